# Optimizing an MI355X kernel written in HIP

```python
import math
import jax, jax.numpy as jnp
from jax import lax
import numpy as np

D_MODEL = 1024
BATCH = 16
SEQ = 2048
DEPTH = 1

HEAD_DIM = 64
NSA_HEADS = 8
NSA_KV_GROUPS = 2
NSA_REP = NSA_HEADS // NSA_KV_GROUPS
SB_HEADS = 8
CMP_BLOCK = 32
CMP_STRIDE = 16
CMP_HIDDEN = 2 * HEAD_DIM
SEL_BLOCK = 64
SEL_TOPK = 8
WINDOW = 512
Q_BLOCK = 128
SEL_Q_CHUNK = 64
D_FF = -(-8 * D_MODEL // (3 * 256)) * 256
RMS_EPS = 1e-6
NEG_INF = -1e30
FORCE_PRIORITY = 1e4
ATTN_SCALE = 1.0 / math.sqrt(HEAD_DIM)

NSA_Q_DIM = NSA_HEADS * HEAD_DIM
NSA_KV_DIM = 6 * NSA_KV_GROUPS * HEAD_DIM
NSA_GATE_DIM = 3 * NSA_HEADS
SB_QKV_DIM = 3 * SB_HEADS * HEAD_DIM
MERGE_DIM = 2 * D_MODEL
D_IN = NSA_Q_DIM + NSA_KV_DIM + NSA_GATE_DIM + SB_QKV_DIM + MERGE_DIM
IN_SPLITS = (NSA_Q_DIM, NSA_Q_DIM + NSA_KV_DIM, NSA_Q_DIM + NSA_KV_DIM + NSA_GATE_DIM,
             NSA_Q_DIM + NSA_KV_DIM + NSA_GATE_DIM + SB_QKV_DIM)

kernel_name = "hybrid_nsa_stickbreaking_gated_block"


def rmsnorm(x, g):
    xf = x.astype(jnp.float32)
    y = xf * lax.rsqrt(jnp.mean(xf * xf, axis=-1, keepdims=True) + RMS_EPS)
    return (y * g.astype(jnp.float32)).astype(x.dtype)


def modulate(h, shift, scale):
    return h * (1.0 + scale) + shift


def alibi_slopes():
    i = jnp.arange(1, NSA_HEADS + 1, dtype=jnp.float32)
    return jnp.exp2(-8.0 * i / NSA_HEADS).reshape(NSA_KV_GROUPS, NSA_REP)


def compress(k, pos_emb, w1, w2):
    n_cmp = (k.shape[2] - CMP_BLOCK) // CMP_STRIDE + 1
    idx = jnp.arange(n_cmp)[:, None] * CMP_STRIDE + jnp.arange(CMP_BLOCK)[None, :]
    blocks = k[:, :, idx] + pos_emb
    flat = blocks.reshape(*blocks.shape[:3], CMP_BLOCK * HEAD_DIM)
    return jax.nn.gelu(flat @ w1) @ w2


def nsa_compressed(q, kc, vc, slopes):
    S = q.shape[3]
    n = kc.shape[2]
    t = jnp.arange(S)
    end = jnp.arange(n) * CMP_STRIDE + CMP_BLOCK - 1
    dist = (t[:, None] - end[None, :]).astype(jnp.float32)
    valid = dist >= 0
    s = jnp.einsum('bgrqd,bgnd->bgrqn', q.astype(jnp.float32), kc.astype(jnp.float32)) * ATTN_SCALE
    s = s - slopes[:, :, None, None] * dist
    s = jnp.where(valid, s, NEG_INF)
    p = jax.nn.softmax(s, axis=-1)
    p = jnp.where(valid.any(-1)[:, None], p, 0.0)
    o = jnp.einsum('bgrqn,bgnd->bgrqd', p.astype(vc.dtype), vc)
    return o, p.sum(axis=2)


def nsa_select_indices(p_cmp, S):
    n_cmp = p_cmp.shape[-1]
    n_sel = S // SEL_BLOCK
    c_start = jnp.arange(n_cmp) * CMP_STRIDE
    c_end = c_start + CMP_BLOCK - 1
    s_start = jnp.arange(n_sel) * SEL_BLOCK
    s_end = s_start + SEL_BLOCK - 1
    overlap = ((c_start[:, None] <= s_end[None, :]) & (c_end[:, None] >= s_start[None, :])).astype(jnp.float32)
    p_slc = jnp.einsum('bgqn,nj->bgqj', p_cmp, overlap)
    cur = (jnp.arange(S) // SEL_BLOCK)[:, None]
    j = jnp.arange(n_sel)[None, :]
    valid = j <= cur
    forced = (j == 0) | (j == cur) | (j == cur - 1)
    prio = jnp.where(valid, p_slc, NEG_INF)
    prio = jnp.where(forced & valid, FORCE_PRIORITY, prio)
    _, idx = lax.top_k(prio, min(SEL_TOPK, n_sel))
    return idx


def nsa_selected(q, k, v, idx, slopes):
    B, G, R, S, hd = q.shape
    n = idx.shape[-1]
    kb = k.reshape(B, G, S // SEL_BLOCK, SEL_BLOCK, hd)
    vb = v.reshape(B, G, S // SEL_BLOCK, SEL_BLOCK, hd)
    nc = S // SEL_Q_CHUNK
    q_c = q.reshape(B, G, R, nc, SEL_Q_CHUNK, hd).transpose(3, 0, 1, 2, 4, 5)
    idx_c = idx.reshape(B, G, nc, SEL_Q_CHUNK, n).transpose(2, 0, 1, 3, 4)
    t_c = jnp.arange(S).reshape(nc, SEL_Q_CHUNK)
    bi = jnp.arange(B)[:, None, None, None]
    gi = jnp.arange(G)[None, :, None, None]

    def chunk(args):
        qq, ii, tt = args
        ks = kb[bi, gi, ii]
        vs = vb[bi, gi, ii]
        pos = ii[..., None] * SEL_BLOCK + jnp.arange(SEL_BLOCK)
        dist = (tt[:, None, None] - pos).astype(jnp.float32)
        s = jnp.einsum('bgrqd,bgqnld->bgrqnl', qq.astype(jnp.float32), ks.astype(jnp.float32)) * ATTN_SCALE
        s = s - slopes[:, :, None, None, None] * dist[:, :, None]
        s = jnp.where((dist >= 0)[:, :, None], s, NEG_INF)
        p = jax.nn.softmax(s, axis=(-2, -1))
        return jnp.einsum('bgrqnl,bgqnld->bgrqd', p.astype(v.dtype), vs)

    o = lax.map(chunk, (q_c, idx_c, t_c))
    return o.transpose(1, 2, 3, 0, 4, 5).reshape(B, G, R, S, hd)


def nsa_window(q, k, v, slopes):
    B, G, R, S, hd = q.shape
    kp = jnp.pad(k, ((0, 0), (0, 0), (WINDOW, 0), (0, 0)))
    vp = jnp.pad(v, ((0, 0), (0, 0), (WINDOW, 0), (0, 0)))
    nq = S // Q_BLOCK
    q_c = q.reshape(B, G, R, nq, Q_BLOCK, hd).transpose(3, 0, 1, 2, 4, 5)
    starts = jnp.arange(nq) * Q_BLOCK
    span = WINDOW + Q_BLOCK

    def blk(args):
        qq, q0 = args
        kk = lax.dynamic_slice_in_dim(kp, q0, span, axis=2)
        vv = lax.dynamic_slice_in_dim(vp, q0, span, axis=2)
        t = q0 + jnp.arange(Q_BLOCK)
        s_pos = q0 - WINDOW + jnp.arange(span)
        dist = t[:, None] - s_pos[None, :]
        mask = (dist >= 0) & (dist < WINDOW) & (s_pos[None, :] >= 0)
        s = jnp.einsum('bgrqd,bgkd->bgrqk', qq.astype(jnp.float32), kk.astype(jnp.float32)) * ATTN_SCALE
        s = s - slopes[:, :, None, None] * dist.astype(jnp.float32)
        s = jnp.where(mask, s, NEG_INF)
        p = jax.nn.softmax(s, axis=-1)
        return jnp.einsum('bgrqk,bgkd->bgrqd', p.astype(v.dtype), vv)

    o = lax.map(blk, (q_c, starts))
    return o.transpose(1, 2, 3, 0, 4, 5).reshape(B, G, R, S, hd)


def stick_breaking(q, k, v):
    B, H, S, hd = q.shape
    nq = S // Q_BLOCK
    q_c = q.reshape(B, H, nq, Q_BLOCK, hd).transpose(2, 0, 1, 3, 4)
    starts = jnp.arange(nq) * Q_BLOCK
    kf = k.astype(jnp.float32)
    s_pos = jnp.arange(S)

    def blk(args):
        qq, q0 = args
        t = q0 + jnp.arange(Q_BLOCK)
        mask = s_pos[None, :] < t[:, None]
        z = jnp.einsum('bhqd,bhkd->bhqk', qq.astype(jnp.float32), kf) * ATTN_SCALE
        log_keep = jnp.where(mask, -jax.nn.softplus(z), 0.0)
        later = lax.cumsum(log_keep, axis=3, reverse=True) - log_keep
        a = jnp.where(mask, jnp.exp(jax.nn.log_sigmoid(z) + later), 0.0)
        return jnp.einsum('bhqk,bhkd->bhqd', a.astype(v.dtype), v)

    o = lax.map(blk, (q_c, starts))
    return o.transpose(1, 2, 0, 3, 4).reshape(B, H, S, hd)


def hybrid_mixer(h, w_in, cmp_pos_k, cmp_w1_k, cmp_w2_k, cmp_pos_v, cmp_w1_v, cmp_w2_v,
                 w_proj_a, w_proj_b, w_out):
    B, S, _ = h.shape
    G, R, hd = NSA_KV_GROUPS, NSA_REP, HEAD_DIM
    proj = h @ w_in
    q_a, kv_a, gate_a, qkv_b, merge = jnp.split(proj, IN_SPLITS, axis=-1)

    q_a = q_a.reshape(B, S, G, R, hd).transpose(0, 2, 3, 1, 4)
    kv_a = kv_a.reshape(B, S, 6, G, hd).transpose(2, 0, 3, 1, 4)
    k_cmp, v_cmp, k_sel, v_sel, k_win, v_win = (kv_a[i] for i in range(6))
    g_a = jax.nn.sigmoid(gate_a.reshape(B, S, G, R, 3).transpose(0, 2, 3, 1, 4))
    slopes = alibi_slopes()
    kc = compress(k_cmp, cmp_pos_k, cmp_w1_k, cmp_w2_k)
    vc = compress(v_cmp, cmp_pos_v, cmp_w1_v, cmp_w2_v)
    o_cmp, p_cmp = nsa_compressed(q_a, kc, vc, slopes)
    idx = nsa_select_indices(p_cmp, S)
    o_sel = nsa_selected(q_a, k_sel, v_sel, idx, slopes)
    o_win = nsa_window(q_a, k_win, v_win, slopes)
    o_a = g_a[..., 0:1] * o_cmp + g_a[..., 1:2] * o_sel + g_a[..., 2:3] * o_win
    y_a = o_a.transpose(0, 3, 1, 2, 4).reshape(B, S, NSA_Q_DIM) @ w_proj_a

    qkv_b = qkv_b.reshape(B, S, 3, SB_HEADS, hd).transpose(2, 0, 3, 1, 4)
    o_b = stick_breaking(qkv_b[0], qkv_b[1], qkv_b[2])
    y_b = o_b.transpose(0, 2, 1, 3).reshape(B, S, SB_HEADS * hd) @ w_proj_b

    merge = merge.reshape(B, S, 2, D_MODEL)
    y = jax.nn.sigmoid(merge[:, :, 0]) * y_a + jax.nn.sigmoid(merge[:, :, 1]) * y_b
    return y @ w_out


def swiglu(h, w_gate, w_up, w_down):
    return (jax.nn.silu(h @ w_gate) * (h @ w_up)) @ w_down


def setup_inputs(seed: int = 0) -> dict:
    key = jax.random.key(seed)
    ks = jax.random.split(key, 20)

    def dense(k, shape, fan_in):
        return jax.random.normal(k, shape, jnp.float32) * (fan_in ** -0.5)

    def gain(k, shape):
        return 1.0 + 0.05 * jax.random.normal(k, shape, jnp.float32)

    L = DEPTH
    cmp_in = CMP_BLOCK * HEAD_DIM
    return {
        "x": jax.random.normal(ks[0], (BATCH, SEQ, D_MODEL), jnp.float32),
        "c": jax.random.normal(ks[1], (BATCH, D_MODEL), jnp.float32),
        "w_ada": dense(ks[2], (L, D_MODEL, 6 * D_MODEL), D_MODEL),
        "b_ada": 0.02 * jax.random.normal(ks[3], (L, 6 * D_MODEL), jnp.float32),
        "norm_mix_g": gain(ks[4], (L, D_MODEL)),
        "w_in": dense(ks[5], (L, D_MODEL, D_IN), D_MODEL),
        "cmp_pos_k": 0.02 * jax.random.normal(ks[6], (L, CMP_BLOCK, HEAD_DIM), jnp.float32),
        "cmp_w1_k": dense(ks[7], (L, cmp_in, CMP_HIDDEN), cmp_in),
        "cmp_w2_k": dense(ks[8], (L, CMP_HIDDEN, HEAD_DIM), CMP_HIDDEN),
        "cmp_pos_v": 0.02 * jax.random.normal(ks[9], (L, CMP_BLOCK, HEAD_DIM), jnp.float32),
        "cmp_w1_v": dense(ks[10], (L, cmp_in, CMP_HIDDEN), cmp_in),
        "cmp_w2_v": dense(ks[11], (L, CMP_HIDDEN, HEAD_DIM), CMP_HIDDEN),
        "w_proj_a": dense(ks[12], (L, NSA_Q_DIM, D_MODEL), NSA_Q_DIM),
        "w_proj_b": dense(ks[13], (L, SB_HEADS * HEAD_DIM, D_MODEL), SB_HEADS * HEAD_DIM),
        "w_out": dense(ks[14], (L, D_MODEL, D_MODEL), D_MODEL),
        "norm_ffn_g": gain(ks[15], (L, D_MODEL)),
        "w_ffn_gate": dense(ks[16], (L, D_MODEL, D_FF), D_MODEL),
        "w_ffn_up": dense(ks[17], (L, D_MODEL, D_FF), D_MODEL),
        "w_ffn_down": dense(ks[18], (L, D_FF, D_MODEL), D_FF),
        "norm_final_g": gain(ks[19], (D_MODEL,)),
    }


def reference(x, c, w_ada, b_ada, norm_mix_g, w_in, cmp_pos_k, cmp_w1_k, cmp_w2_k,
              cmp_pos_v, cmp_w1_v, cmp_w2_v, w_proj_a, w_proj_b, w_out, norm_ffn_g,
              w_ffn_gate, w_ffn_up, w_ffn_down, norm_final_g):
    for l in range(DEPTH):
        mod = jax.nn.silu(c) @ w_ada[l] + b_ada[l]
        sh1, sc1, g1, sh2, sc2, g2 = jnp.split(mod[:, None, :], 6, axis=-1)
        h = modulate(rmsnorm(x, norm_mix_g[l]), sh1, sc1)
        x = x + g1 * hybrid_mixer(h, w_in[l], cmp_pos_k[l], cmp_w1_k[l], cmp_w2_k[l],
                                  cmp_pos_v[l], cmp_w1_v[l], cmp_w2_v[l],
                                  w_proj_a[l], w_proj_b[l], w_out[l])
        h = modulate(rmsnorm(x, norm_ffn_g[l]), sh2, sc2)
        x = x + g2 * swiglu(h, w_ffn_gate[l], w_ffn_up[l], w_ffn_down[l])
    return rmsnorm(x, norm_final_g)
```

```cpp
#include <hip/hip_runtime.h>
#include <hip/hip_cooperative_groups.h>
#include <cstdio>
#include <cstdint>
#include <cmath>
namespace cg = cooperative_groups;
namespace pg8 {
#define PG8_LAS __attribute__((address_space(3)))
typedef unsigned short bf16_t;
typedef short bf16x8 __attribute__((ext_vector_type(8)));
typedef float f32x4 __attribute__((ext_vector_type(4)));
typedef unsigned u32x4 __attribute__((ext_vector_type(4)));
constexpr int BM = 256, BK = 64, HALF = 128, HTB = HALF * BK * 2  , STAGE_BYTES = 8 * HTB, NXCD = 8, WGM = 8;

__host__ __device__ __forceinline__ int lds_byte(int r, int c) { const int st = (r >> 4) * 2 + (c >> 5), rr = r & 15, cc = c & 31, ob = rr * 64 + cc * 2; return st * 1024 + (ob ^ (((ob >> 9) & 1) << 5)); }
__host__ __device__ __forceinline__ void stage_rc(int b, int& R, int& C) { const int st = b / 1024, sb = b % 1024, swz = sb ^ (((sb >> 9) & 1) << 5); R = (st >> 1) * 16 + swz / 64; C = (st & 1) * 32 + (swz % 64) / 2; }
__host__ __device__ __forceinline__ int perm32(int rho) { const int n = rho >> 4, i = rho & 15; return 8 * (i >> 2) + 4 * n + (i & 3); }

struct Unit { int pm, pn; };
struct Gemm { const bf16_t* A; const bf16_t* Bt; int M, N, K; };

struct StaticOrder {
    int nM, nN, nwg, G, c;
    __host__ __device__ void init(int M, int N, int G_, int c_) { nM = M / BM; nN = N / BM; nwg = nM * nN; G = G_; c = c_; }
    __host__ __device__ bool next(int i, Unit& u) const {
        const long L = (long)i * G + c; if (L >= nwg) return false;
        int wgid = (int)L; { const int q = nwg / NXCD, r = nwg % NXCD, xcd = wgid % NXCD, off = wgid / NXCD; wgid = (xcd < r ? xcd * (q + 1) : r * (q + 1) + (xcd - r) * q) + off; }
        const int nig = WGM * nN, gid = wgid / nig, fm = gid * WGM, gsz = (nM - fm) < WGM ? (nM - fm) : WGM;
        u.pm = fm + ((wgid % nig) % gsz); u.pn = (wgid % nig) / gsz; return true;
    }
    __device__ __forceinline__ void a_ready(const Unit&) const {}
    __device__ __forceinline__ void done(const Unit&) const {}
};

__device__ __forceinline__ unsigned cvt_pk_bf16(float lo, float hi) { unsigned r; asm volatile("v_cvt_pk_bf16_f32 %0, %1, %2" : "=v"(r) : "v"(lo), "v"(hi)); return r; }
template <class Epi, class Sched, bool ALIGN_EPI = false, bool SP2 = false>
__device__ __forceinline__ void gemm_phase(PG8_LAS unsigned char* lds, const Gemm g, const Sched& S, const Epi& E) {
    const int tid = threadIdx.x, wid = __builtin_amdgcn_readfirstlane(tid >> 6), lane = tid & 63, wr = wid >> 2, wc = wid & 3, fr = lane & 15, fq = lane >> 4;
    const int K = g.K, nt = K / BK;
    unsigned voffA[2], voffB[2];
#pragma unroll
    for (int i = 0; i < 2; ++i) { int R, C; stage_rc(tid * 16 + i * 8192, R, C); const int Rb = Epi::PERM ? ((R & ~31) + perm32(R & 31)) : R;
        voffA[i] = (unsigned)(R * K + C) * 2u; voffB[i] = (unsigned)(Rb * K + C) * 2u; }
    const size_t kstep = (size_t)(BK * 2);
    const size_t hstep = (size_t)HALF * K * 2;
    const size_t tstep = 2 * hstep;
    const unsigned ldsw = (unsigned)wid * 1024u;
    const int aoff = lds_byte(wr * 64 + fr, fq * 8), boff = lds_byte(wc * 32 + fr, fq * 8);
#define PG8_SA(b, h) (((b) * 2 + (h)) * HTB)
#define PG8_SB(b, h) ((4 + (b) * 2 + (h)) * HTB)
#define PG8_STAGE(bufoff, gbase, voff) do { _Pragma("unroll") for (int _i = 0; _i < 2; ++_i) \
        __builtin_amdgcn_global_load_lds((const unsigned*)((const char*)(gbase) + (voff)[_i]), (PG8_LAS unsigned*)(lds + (bufoff) + ldsw + _i * 8192), 16, 0, 0); } while (0)
#define PG8_LDA(dst, b, h) do { _Pragma("unroll") for (int m = 0; m < 4; ++m) _Pragma("unroll") for (int k = 0; k < 2; ++k) dst[m][k] = *(const PG8_LAS bf16x8*)(lds + PG8_SA(b, h) + aoff + m * 2048 + k * 1024); } while (0)
#define PG8_LDB(dst, b, h) do { _Pragma("unroll") for (int n = 0; n < 2; ++n) _Pragma("unroll") for (int k = 0; k < 2; ++k) dst[n][k] = *(const PG8_LAS bf16x8*)(lds + PG8_SB(b, h) + boff + n * 2048 + k * 1024); } while (0)
#define PG8_MMA(ai, bj, At, Bt) do { __builtin_amdgcn_s_setprio(1); _Pragma("unroll") for (int m = 0; m < 4; ++m) _Pragma("unroll") for (int n = 0; n < 2; ++n) _Pragma("unroll") for (int k = 0; k < 2; ++k) \
        acc[ai][bj][m][n] = __builtin_amdgcn_mfma_f32_16x16x32_bf16(Bt[n][k], At[m][k], acc[ai][bj][m][n], 0, 0, 0); __builtin_amdgcn_s_setprio(0); } while (0)
#define PG8_WAIT_V(n) asm volatile("s_waitcnt vmcnt(" #n ")" ::: "memory")
#define PG8_WAIT_L(n) asm volatile("s_waitcnt lgkmcnt(" #n ")" ::: "memory")
#define PG8_BAR __builtin_amdgcn_s_barrier()
#define PG8_SCHED __builtin_amdgcn_sched_barrier(0)
    Unit cur, nxt; int ui = 0;
    if (!S.next(0, cur)) return;
    f32x4 acc[2][2][4][2];
#pragma unroll
    for (int a = 0; a < 2; ++a)
#pragma unroll
        for (int b = 0; b < 2; ++b)
#pragma unroll
            for (int m = 0; m < 4; ++m)
#pragma unroll
                for (int n = 0; n < 2; ++n) acc[a][b][m][n] = (f32x4){0.f, 0.f, 0.f, 0.f};
    bf16x8 At[4][2], B0[2][2], B1[2][2];
    const char* cA = (const char*)g.A + (size_t)cur.pm * tstep; const char* cB = (const char*)g.Bt + (size_t)cur.pn * tstep;
    S.a_ready(cur);
    if constexpr (SP2) {
        PG8_STAGE(PG8_SB(0, 0), cB, voffB); PG8_STAGE(PG8_SB(0, 1), cB + hstep, voffB); PG8_STAGE(PG8_SA(0, 0), cA, voffA); PG8_STAGE(PG8_SA(0, 1), cA + hstep, voffA);
        if (wr == 1) PG8_BAR;
        PG8_WAIT_V(2); PG8_BAR;
        PG8_STAGE(PG8_SB(1, 0), cB + kstep, voffB); PG8_STAGE(PG8_SA(1, 0), cA + kstep, voffA); PG8_STAGE(PG8_SB(1, 1), cB + hstep + kstep, voffB);
        PG8_WAIT_V(6); PG8_BAR;
    } else {
        PG8_STAGE(PG8_SB(0, 0), cB, voffB); PG8_STAGE(PG8_SA(0, 0), cA, voffA); PG8_STAGE(PG8_SB(0, 1), cB + hstep, voffB); PG8_STAGE(PG8_SA(0, 1), cA + hstep, voffA);
        if (wr == 1) PG8_BAR;
        PG8_WAIT_V(4); PG8_BAR;
        PG8_STAGE(PG8_SB(1, 0), cB + kstep, voffB); PG8_STAGE(PG8_SA(1, 0), cA + kstep, voffA); PG8_STAGE(PG8_SB(1, 1), cB + hstep + kstep, voffB);
        PG8_WAIT_V(6); PG8_BAR;
    }
    for (;;) {
        const bool has_next = S.next(ui + 1, nxt);
        const char* nA = has_next ? (const char*)g.A + (size_t)nxt.pm * tstep : cA; const char* nB = has_next ? (const char*)g.Bt + (size_t)nxt.pn * tstep : cB;
        for (int t = 0; t < nt; t += 2) {
            const bool last = (t == nt - 2);
            const char* a1 = cA + (size_t)(t + 1) * kstep;
            const char* a2 = last ? nA : cA + (size_t)(t + 2) * kstep; const char* b2 = last ? nB : cB + (size_t)(t + 2) * kstep;
            const char* a3 = a2 + kstep; const char* b3 = b2 + kstep;
            if (last && has_next) S.a_ready(nxt);
            if constexpr (SP2) {
            PG8_LDB(B0, 0, 0); PG8_LDB(B1, 0, 1); PG8_SCHED; PG8_LDA(At, 0, 0); PG8_STAGE(PG8_SA(1, 1), a1 + hstep, voffA);
            PG8_WAIT_V(8); PG8_WAIT_L(0); PG8_BAR; PG8_MMA(0, 0, At, B0); PG8_MMA(0, 1, At, B1); PG8_BAR; PG8_SCHED;
            PG8_LDA(At, 0, 1); PG8_STAGE(PG8_SB(0, 0), b2, voffB); PG8_STAGE(PG8_SB(0, 1), b2 + hstep, voffB); PG8_STAGE(PG8_SA(0, 0), a2, voffA);
            PG8_WAIT_V(8); PG8_WAIT_L(0); PG8_BAR; PG8_MMA(1, 0, At, B0); PG8_MMA(1, 1, At, B1); PG8_BAR; PG8_SCHED;
            PG8_LDB(B0, 1, 0); PG8_LDB(B1, 1, 1); PG8_SCHED; PG8_LDA(At, 1, 0); PG8_STAGE(PG8_SA(0, 1), a2 + hstep, voffA);
            PG8_WAIT_V(8); PG8_WAIT_L(0); PG8_BAR; PG8_MMA(0, 0, At, B0); PG8_MMA(0, 1, At, B1); PG8_BAR; PG8_SCHED;
            PG8_LDA(At, 1, 1); PG8_STAGE(PG8_SB(1, 0), b3, voffB); PG8_STAGE(PG8_SB(1, 1), b3 + hstep, voffB); PG8_STAGE(PG8_SA(1, 0), a3, voffA);
            PG8_WAIT_V(8); PG8_WAIT_L(0); PG8_BAR; PG8_MMA(1, 0, At, B0); PG8_MMA(1, 1, At, B1); PG8_BAR; PG8_SCHED;
            } else {
            PG8_LDB(B0, 0, 0); PG8_SCHED; PG8_LDA(At, 0, 0); PG8_STAGE(PG8_SA(1, 1), a1 + hstep, voffA);
            PG8_WAIT_L(8); PG8_BAR; PG8_WAIT_L(0); PG8_MMA(0, 0, At, B0); PG8_BAR; PG8_SCHED;
            PG8_LDB(B1, 0, 1); PG8_STAGE(PG8_SB(0, 0), b2, voffB);
            PG8_BAR; PG8_WAIT_L(0); PG8_MMA(0, 1, At, B1); PG8_BAR;
            PG8_LDA(At, 0, 1); PG8_STAGE(PG8_SA(0, 0), a2, voffA);
            PG8_BAR; PG8_WAIT_L(0); PG8_MMA(1, 0, At, B0); PG8_BAR; PG8_SCHED;
            PG8_STAGE(PG8_SB(0, 1), b2 + hstep, voffB);
            PG8_WAIT_V(6); PG8_BAR; PG8_MMA(1, 1, At, B1); PG8_BAR;
            PG8_LDB(B0, 1, 0); PG8_SCHED; PG8_LDA(At, 1, 0); PG8_STAGE(PG8_SA(0, 1), a2 + hstep, voffA);
            PG8_WAIT_L(8); PG8_BAR; PG8_WAIT_L(0); PG8_MMA(0, 0, At, B0); PG8_BAR; PG8_SCHED;
            PG8_LDB(B1, 1, 1); PG8_STAGE(PG8_SB(1, 0), b3, voffB);
            PG8_BAR; PG8_WAIT_L(0); PG8_MMA(0, 1, At, B1); PG8_BAR;
            PG8_LDA(At, 1, 1); PG8_STAGE(PG8_SA(1, 0), a3, voffA);
            PG8_BAR; PG8_WAIT_L(0); PG8_MMA(1, 0, At, B0); PG8_BAR; PG8_SCHED;
            PG8_STAGE(PG8_SB(1, 1), b3 + hstep, voffB);
            PG8_WAIT_V(6); PG8_BAR; PG8_MMA(1, 1, At, B1); PG8_BAR;
            }
        }
        if constexpr (ALIGN_EPI) { if (wr == 0) PG8_BAR; }
        if constexpr (!Epi::AFTER_DRAIN) { E(acc, cur, wr, wc, fr, fq); S.done(cur); }
        if (!has_next) break;
#pragma unroll
        for (int a = 0; a < 2; ++a)
#pragma unroll
            for (int b = 0; b < 2; ++b)
#pragma unroll
                for (int m = 0; m < 4; ++m)
#pragma unroll
                    for (int n = 0; n < 2; ++n) acc[a][b][m][n] = (f32x4){0.f, 0.f, 0.f, 0.f};
        cur = nxt; cA = nA; cB = nB; ++ui;
        if constexpr (ALIGN_EPI) { if (wr == 1) PG8_BAR; }
    }
    PG8_WAIT_V(0);
    if constexpr (!ALIGN_EPI) { if (wr == 0) PG8_BAR; }
    PG8_BAR;
    if constexpr (Epi::AFTER_DRAIN) { E.fused(acc, cur, wr, wc, fr, fq, lds, wid, lane); S.done(cur); }
#undef PG8_SA
#undef PG8_SB
#undef PG8_STAGE
#undef PG8_LDA
#undef PG8_LDB
#undef PG8_MMA
#undef PG8_WAIT_V
#undef PG8_WAIT_L
#undef PG8_BAR
#undef PG8_SCHED
}
}

#define LAS __attribute__((address_space(3)))
#define DI __device__ __forceinline__
typedef unsigned short bf16_t;
typedef short bf16x8 __attribute__((ext_vector_type(8)));
typedef float f32x4 __attribute__((ext_vector_type(4)));
typedef float f32x16 __attribute__((ext_vector_type(16)));
typedef unsigned u32x4 __attribute__((ext_vector_type(4)));
typedef unsigned u32x2 __attribute__((ext_vector_type(2)));
typedef float f32x2_t __attribute__((ext_vector_type(2)));
typedef __bf16 bf16x2_t __attribute__((ext_vector_type(2)));

constexpr int NB = 16, SEQ = 2048, DM = 1024, MT = NB * SEQ;
constexpr int DIN = 4888, DINP = 5120, DFF = 2816, DGU = 2 * DFF;
constexpr int C_QA = 0, C_KVA = 512, C_GA = 1280, C_QB = 1304, C_KB = 1816, C_VB = 2328, C_MG = 2840;
constexpr float LOG2E = 1.4426950408889634f;
constexpr float QSCALE = 0.125f * LOG2E;
constexpr float RMS_EPS = 1e-6f;
constexpr int NWAVES = 8, NTHREADS = 512;
constexpr int LDS_BYTES = 147456;

constexpr size_t MiB = 1u << 20;
constexpr size_t WS_SUMSQ2 = 0, WS_SUMSQ3 = 128 * 1024, WS_MOD = 256 * 1024, WS_BIASGU = 1 * MiB, WS_KC = 2 * MiB, WS_VC = 2 * MiB + 512 * 1024;
constexpr size_t WS_WIN = 4 * MiB, WS_WPA = 14 * MiB, WS_WPB = 15 * MiB, WS_WOUT = 16 * MiB, WS_WGU = 18 * MiB, WS_WD = 29 * MiB;
constexpr size_t WS_CW1K = 35 * MiB, WS_CW1V = 35 * MiB + 512 * 1024, WS_CW2K = 36 * MiB, WS_CW2V = 36 * MiB + 64 * 1024;
constexpr size_t WS_H = 40 * MiB;
constexpr size_t WS_PROJ = 104 * MiB;
constexpr size_t WS_OA = 424 * MiB, WS_OB = 456 * MiB;
constexpr size_t WS_END = 488 * MiB;

DI float bf2f(unsigned short v) { return __uint_as_float((unsigned)v << 16); }
DI unsigned cvtpk(float lo, float hi) { f32x2_t v = {lo, hi}; bf16x2_t b = __builtin_convertvector(v, bf16x2_t); return __builtin_bit_cast(unsigned, b); }
DI float fast_exp2(float x) { return __builtin_amdgcn_exp2f(x); }
DI float fast_log2(float x) { return __builtin_amdgcn_logf(x); }
DI float fast_rcp(float x) { return __builtin_amdgcn_rcpf(x); }
DI float sigmoidf_(float x) { return fast_rcp(1.0f + fast_exp2(-x * LOG2E)); }
DI float wave_sum(float v) {
#pragma unroll
    for (int o = 1; o < 64; o <<= 1) v += __shfl_xor(v, o);
    return v;
}
#define LDS_WAIT() asm volatile("s_waitcnt lgkmcnt(0)" ::: "memory")

using pg8::Unit;
struct EpiProj {
    static constexpr bool PERM = true, AFTER_DRAIN = false;
    bf16_t* O;
    DI void operator()(const f32x4 (&acc)[2][2][4][2], const Unit& u, int wr, int wc, int fr, int fq) const {
        const int row0 = u.pm * 256 + wr * 64 + fr, colb = u.pn * 256 + wc * 32 + 8 * fq;
#pragma unroll
        for (int ai = 0; ai < 2; ++ai)
#pragma unroll
            for (int m = 0; m < 4; ++m) {
                bf16_t* rowp = O + (size_t)(row0 + ai * 128 + m * 16) * DINP + colb;
#pragma unroll
                for (int bj = 0; bj < 2; ++bj) {
                    const int col = colb + bj * 128;
                    const bool sg = (col >= C_GA && col < C_QB) || (col >= C_MG);
                    f32x4 v0 = acc[ai][bj][m][0], v1 = acc[ai][bj][m][1];
                    if (sg) {
#pragma unroll
                        for (int e = 0; e < 4; ++e) { v0[e] = sigmoidf_(v0[e]); v1[e] = sigmoidf_(v1[e]); }
                    }
                    u32x4 w; w.x = cvtpk(v0[0], v0[1]); w.y = cvtpk(v0[2], v0[3]); w.z = cvtpk(v1[0], v1[1]); w.w = cvtpk(v1[2], v1[3]);
                    *(u32x4*)(rowp + bj * 128) = w;
                }
            }
    }
};
template <int PASS> struct EpiMerge {
    static constexpr bool PERM = true, AFTER_DRAIN = false;
    const bf16_t* proj; bf16_t* Y;
    DI void operator()(const f32x4 (&acc)[2][2][4][2], const Unit& u, int wr, int wc, int fr, int fq) const {
        const int row0 = u.pm * 256 + wr * 64 + fr, colb = u.pn * 256 + wc * 32 + 8 * fq;
#pragma unroll
        for (int ai = 0; ai < 2; ++ai)
#pragma unroll
            for (int m = 0; m < 4; ++m) {
                const size_t row = (size_t)(row0 + ai * 128 + m * 16);
#pragma unroll
                for (int bj = 0; bj < 2; ++bj) {
                    const int col = colb + bj * 128;
                    const u32x4 mg = *(const u32x4*)(proj + row * DINP + C_MG + PASS * DM + col);
                    f32x4 v0 = acc[ai][bj][m][0], v1 = acc[ai][bj][m][1];
                    v0[0] *= __uint_as_float(mg.x << 16); v0[1] *= __uint_as_float(mg.x & 0xffff0000u);
                    v0[2] *= __uint_as_float(mg.y << 16); v0[3] *= __uint_as_float(mg.y & 0xffff0000u);
                    v1[0] *= __uint_as_float(mg.z << 16); v1[1] *= __uint_as_float(mg.z & 0xffff0000u);
                    v1[2] *= __uint_as_float(mg.w << 16); v1[3] *= __uint_as_float(mg.w & 0xffff0000u);
                    bf16_t* yp = Y + row * DM + col;
                    if (PASS == 1) {
                        const u32x4 pv = *(const u32x4*)yp;
                        v0[0] += __uint_as_float(pv.x << 16); v0[1] += __uint_as_float(pv.x & 0xffff0000u);
                        v0[2] += __uint_as_float(pv.y << 16); v0[3] += __uint_as_float(pv.y & 0xffff0000u);
                        v1[0] += __uint_as_float(pv.z << 16); v1[1] += __uint_as_float(pv.z & 0xffff0000u);
                        v1[2] += __uint_as_float(pv.w << 16); v1[3] += __uint_as_float(pv.w & 0xffff0000u);
                    }
                    u32x4 w; w.x = cvtpk(v0[0], v0[1]); w.y = cvtpk(v0[2], v0[3]); w.z = cvtpk(v1[0], v1[1]); w.w = cvtpk(v1[2], v1[3]);
                    *(u32x4*)yp = w;
                }
            }
    }
};
struct EpiOut {
    static constexpr bool PERM = false, AFTER_DRAIN = false;
    const float* x; float* x1; bf16_t* apre; const float* mod; const float* gffn; float* sumsq;
    DI void operator()(const f32x4 (&acc)[2][2][4][2], const Unit& u, int wr, int wc, int fr, int fq) const {
        const int b = u.pm >> 3, colb = u.pn * 256 + wc * 32 + 4 * fq;
        f32x4 g1v[2][2], mul[2][2];
#pragma unroll
        for (int bj = 0; bj < 2; ++bj)
#pragma unroll
            for (int n = 0; n < 2; ++n) {
                const int col = colb + bj * 128 + n * 16;
                g1v[bj][n] = *(const f32x4*)(mod + b * 6144 + 2 * DM + col);
                const f32x4 sc = *(const f32x4*)(mod + b * 6144 + 4 * DM + col), gg = *(const f32x4*)(gffn + col);
                mul[bj][n] = gg * (sc + 1.0f);
            }
#pragma unroll
        for (int ai = 0; ai < 2; ++ai)
#pragma unroll
            for (int m = 0; m < 4; ++m) {
                const size_t row = (size_t)(u.pm * 256 + ai * 128 + wr * 64 + m * 16 + fr);
                float ss = 0.f;
#pragma unroll
                for (int bj = 0; bj < 2; ++bj)
#pragma unroll
                    for (int n = 0; n < 2; ++n) {
                        const size_t off = row * DM + colb + bj * 128 + n * 16;
                        const f32x4 xv = *(const f32x4*)(x + off);
                        const f32x4 v = xv + g1v[bj][n] * acc[ai][bj][m][n];
                        *(f32x4*)(x1 + off) = v;
                        ss += (v[0] * v[0] + v[1] * v[1]) + (v[2] * v[2] + v[3] * v[3]);
                        const f32x4 a = v * mul[bj][n];
                        u32x2 w; w.x = cvtpk(a[0], a[1]); w.y = cvtpk(a[2], a[3]);
                        *(u32x2*)(apre + off) = w;
                    }
                ss += __shfl_xor(ss, 16); ss += __shfl_xor(ss, 32);
                if (fq == 0) atomicAdd(sumsq + row, ss);
            }
    }
};
struct EpiGU {
    static constexpr bool PERM = true, AFTER_DRAIN = false;
    const float* sumsq; const float* biasgu; bf16_t* act;
    DI void operator()(const f32x4 (&acc)[2][2][4][2], const Unit& u, int wr, int wc, int fr, int fq) const {
        const int b = u.pm >> 3, colb = u.pn * 256 + wc * 32 + 8 * fq;
        f32x4 bg[2], bu[2];
#pragma unroll
        for (int bj = 0; bj < 2; ++bj) { bg[bj] = *(const f32x4*)(biasgu + b * DGU + colb + bj * 128); bu[bj] = *(const f32x4*)(biasgu + b * DGU + colb + bj * 128 + 4); }
#pragma unroll
        for (int ai = 0; ai < 2; ++ai)
#pragma unroll
            for (int m = 0; m < 4; ++m) {
                const size_t row = (size_t)(u.pm * 256 + ai * 128 + wr * 64 + m * 16 + fr);
                const float rstd = 1.0f / sqrtf(sumsq[row] * (1.0f / DM) + RMS_EPS);
#pragma unroll
                for (int bj = 0; bj < 2; ++bj) {
                    const f32x4 gv = acc[ai][bj][m][0] * rstd + bg[bj], uv = acc[ai][bj][m][1] * rstd + bu[bj];
                    float a[4];
#pragma unroll
                    for (int e = 0; e < 4; ++e) a[e] = gv[e] * sigmoidf_(gv[e]) * uv[e];
                    u32x2 w; w.x = cvtpk(a[0], a[1]); w.y = cvtpk(a[2], a[3]);
                    *(u32x2*)(act + row * DFF + ((colb + bj * 128) >> 1)) = w;
                }
            }
    }
};
struct EpiDown {
    static constexpr bool PERM = false, AFTER_DRAIN = false;
    float* xio; const float* mod; float* sumsq;
    DI void operator()(const f32x4 (&acc)[2][2][4][2], const Unit& u, int wr, int wc, int fr, int fq) const {
        const int b = u.pm >> 3, colb = u.pn * 256 + wc * 32 + 4 * fq;
        f32x4 g2v[2][2];
#pragma unroll
        for (int bj = 0; bj < 2; ++bj)
#pragma unroll
            for (int n = 0; n < 2; ++n) g2v[bj][n] = *(const f32x4*)(mod + b * 6144 + 5 * DM + colb + bj * 128 + n * 16);
#pragma unroll
        for (int ai = 0; ai < 2; ++ai)
#pragma unroll
            for (int m = 0; m < 4; ++m) {
                const size_t row = (size_t)(u.pm * 256 + ai * 128 + wr * 64 + m * 16 + fr);
                float ss = 0.f;
#pragma unroll
                for (int bj = 0; bj < 2; ++bj)
#pragma unroll
                    for (int n = 0; n < 2; ++n) {
                        float* p = xio + row * DM + colb + bj * 128 + n * 16;
                        const f32x4 v = *(const f32x4*)p + g2v[bj][n] * acc[ai][bj][m][n];
                        *(f32x4*)p = v;
                        ss += (v[0] * v[0] + v[1] * v[1]) + (v[2] * v[2] + v[3] * v[3]);
                    }
                ss += __shfl_xor(ss, 16); ss += __shfl_xor(ss, 32);
                if (fq == 0) atomicAdd(sumsq + row, ss);
            }
    }
};

template <class F>
DI void transpose_item(const float* __restrict__ W, int K, int N, bf16_t* WT, LAS float* scr, int item, int nblk, int lane, F f) {
    const int kb = item / nblk, nb = item % nblk, k0 = 64 * kb, n0 = 32 * nb;
    const int nn = n0 + (lane & 31);
#pragma unroll 8
    for (int i = 0; i < 32; ++i) { const int kk = 2 * i + (lane >> 5); scr[kk * 33 + (lane & 31)] = (nn < N) ? W[(size_t)(k0 + kk) * N + nn] : 0.f; }
    LDS_WAIT(); asm volatile("" ::: "memory");
    const int c = lane & 7;
#pragma unroll
    for (int j = 0; j < 4; ++j) {
        const int nl = (lane >> 3) + 8 * j; int row; float sc; f(n0 + nl, row, sc);
        const LAS float* s = scr + (8 * c) * 33 + nl;
        u32x4 o; o.x = cvtpk(s[0 * 33] * sc, s[1 * 33] * sc); o.y = cvtpk(s[2 * 33] * sc, s[3 * 33] * sc); o.z = cvtpk(s[4 * 33] * sc, s[5 * 33] * sc); o.w = cvtpk(s[6 * 33] * sc, s[7 * 33] * sc);
        *(u32x4*)(WT + (size_t)row * K + k0 + 8 * c) = o;
    }
    LDS_WAIT(); asm volatile("" ::: "memory");
}
struct MapId { DI void operator()(int n, int& row, float& sc) const { row = n; sc = 1.f; } };
struct MapWin { DI void operator()(int n, int& row, float& sc) const { row = n; sc = (n < 512 || (n >= C_QB && n < C_KB)) ? QSCALE : 1.f; } };
struct MapGate { DI void operator()(int n, int& row, float& sc) const { row = 8 * (n >> 2) + (n & 3); sc = 1.f; } };
struct MapUp { DI void operator()(int n, int& row, float& sc) const { row = 8 * (n >> 2) + 4 + (n & 3); sc = 1.f; } };

template <class OM>
DI void gemv16_unit(const LAS float* inl, LAS float* red, const float* __restrict__ W, int ldw, int col0, const float* bias, float* out, int ldo, OM om, int tid) {
    const int cl = tid & 31, kg = tid >> 5;
    float acc[16];
#pragma unroll
    for (int b = 0; b < 16; ++b) acc[b] = 0.f;
    const float* wp = W + (size_t)(kg * 64) * ldw + col0 + cl;
#pragma unroll 4
    for (int kk = 0; kk < 64; ++kk) {
        const float w = wp[(size_t)kk * ldw];
        const LAS f32x4* ip = (const LAS f32x4*)(inl + (kg * 64 + kk) * 16);
        const f32x4 a0 = ip[0], a1 = ip[1], a2 = ip[2], a3 = ip[3];
        acc[0] += a0[0] * w; acc[1] += a0[1] * w; acc[2] += a0[2] * w; acc[3] += a0[3] * w;
        acc[4] += a1[0] * w; acc[5] += a1[1] * w; acc[6] += a1[2] * w; acc[7] += a1[3] * w;
        acc[8] += a2[0] * w; acc[9] += a2[1] * w; acc[10] += a2[2] * w; acc[11] += a2[3] * w;
        acc[12] += a3[0] * w; acc[13] += a3[1] * w; acc[14] += a3[2] * w; acc[15] += a3[3] * w;
    }
#pragma unroll
    for (int b = 0; b < 16; ++b) red[(kg * 16 + b) * 32 + cl] = acc[b];
    __syncthreads();
    {
        const int b = tid >> 5; float s = 0.f;
#pragma unroll
        for (int g = 0; g < 16; ++g) s += red[(g * 16 + b) * 32 + cl];
        const int col = col0 + cl;
        if (bias) s += bias[col];
        out[(size_t)b * ldo + om(col)] = s;
    }
    __syncthreads();
}
struct OmId { DI int operator()(int c) const { return c; } };
struct OmGate { DI int operator()(int c) const { return 8 * (c >> 2) + (c & 3); } };
struct OmUp { DI int operator()(int c) const { return 8 * (c >> 2) + 4 + (c & 3); } };

constexpr int TS = 72;
constexpr int TILE_B = 64 * TS * 2;
constexpr int L_KT0 = 0, L_VT0 = 2 * TILE_B, L_SLAB = 4 * TILE_B, L_PCMP = L_SLAB + 65536, L_PSLC = L_PCMP + 32768, L_SELM = L_PSLC + 8192, L_UNI = L_SELM + 256;
static_assert(L_UNI + 16 <= LDS_BYTES, "lds");
#define MFMA32(a, b, c) __builtin_amdgcn_mfma_f32_32x32x16_bf16((a), (b), (c), 0, 0, 0)
DI int ci16(int i) { return (i & 3) + 8 * (i >> 2); }

struct TileRegs { u32x4 k, v; };
DI void tile_gload(TileRegs& r, const bf16_t* base, int ld, int row0, int colK, int colV, int tid) {
    r.k = *(const u32x4*)(base + (size_t)(row0 + (tid >> 3)) * ld + colK + (tid & 7) * 8);
    r.v = *(const u32x4*)(base + (size_t)(row0 + (tid & 63)) * ld + colV + (tid >> 6) * 8);
}
DI void tile_lstore(const TileRegs& r, LAS unsigned char* kt, LAS unsigned char* vt, int tid) {
    *(LAS u32x4*)(kt + ((tid >> 3) * TS + (tid & 7) * 8) * 2) = r.k;
    LAS bf16_t* v = (LAS bf16_t*)vt + ((tid >> 6) * 8) * TS + (tid & 63);
    v[0 * TS] = (bf16_t)(r.v.x & 0xffff); v[1 * TS] = (bf16_t)(r.v.x >> 16);
    v[2 * TS] = (bf16_t)(r.v.y & 0xffff); v[3 * TS] = (bf16_t)(r.v.y >> 16);
    v[4 * TS] = (bf16_t)(r.v.z & 0xffff); v[5 * TS] = (bf16_t)(r.v.z >> 16);
    v[6 * TS] = (bf16_t)(r.v.w & 0xffff); v[7 * TS] = (bf16_t)(r.v.w >> 16);
}
DI void qk_tile(f32x16& p0, f32x16& p1, const LAS unsigned char* kt, const bf16x8 (&qf)[4], int r32, int h) {
    const LAS unsigned char* kp = kt + (r32 * TS + 8 * h) * 2;
#pragma unroll
    for (int ds = 0; ds < 4; ++ds) {
        const bf16x8 k0 = *(const LAS bf16x8*)(kp + ds * 32);
        const bf16x8 k1 = *(const LAS bf16x8*)(kp + 32 * TS * 2 + ds * 32);
        p0 = MFMA32(k0, qf[ds], p0);
        p1 = MFMA32(k1, qf[ds], p1);
    }
}
DI void pv_tile(f32x16 (&o)[2], const LAS unsigned char* vt, const bf16x8 (&pf)[4], int r32, int h) {
#pragma unroll
    for (int d0 = 0; d0 < 2; ++d0) {
        const LAS unsigned char* vp = vt + ((32 * d0 + r32) * TS + 4 * h) * 2;
#pragma unroll
        for (int ps = 0; ps < 4; ++ps) {
            const u32x2 lo = *(const LAS u32x2*)(vp + ps * 32);
            const u32x2 hi = *(const LAS u32x2*)(vp + ps * 32 + 16);
            u32x4 a; a.x = lo.x; a.y = lo.y; a.z = hi.x; a.w = hi.y;
            o[d0] = MFMA32(__builtin_bit_cast(bf16x8, a), pf[ps], o[d0]);
        }
    }
}
DI void pack_p(bf16x8 (&pf)[4], const f32x16& p0, const f32x16& p1) {
#pragma unroll
    for (int s = 0; s < 2; ++s) {
        u32x4 a, b;
        a.x = cvtpk(p0[8 * s + 0], p0[8 * s + 1]); a.y = cvtpk(p0[8 * s + 2], p0[8 * s + 3]); a.z = cvtpk(p0[8 * s + 4], p0[8 * s + 5]); a.w = cvtpk(p0[8 * s + 6], p0[8 * s + 7]);
        b.x = cvtpk(p1[8 * s + 0], p1[8 * s + 1]); b.y = cvtpk(p1[8 * s + 2], p1[8 * s + 3]); b.z = cvtpk(p1[8 * s + 4], p1[8 * s + 5]); b.w = cvtpk(p1[8 * s + 6], p1[8 * s + 7]);
        pf[s] = __builtin_bit_cast(bf16x8, a); pf[2 + s] = __builtin_bit_cast(bf16x8, b);
    }
}
DI void store_ot(bf16_t* dst  , const f32x16 (&o)[2], int h) {
#pragma unroll
    for (int d0 = 0; d0 < 2; ++d0)
#pragma unroll
        for (int g4 = 0; g4 < 4; ++g4) {
            u32x2 w; w.x = cvtpk(o[d0][4 * g4 + 0], o[d0][4 * g4 + 1]); w.y = cvtpk(o[d0][4 * g4 + 2], o[d0][4 * g4 + 3]);
            *(u32x2*)(dst + 32 * d0 + 8 * g4 + 4 * h) = w;
        }
}
constexpr float NEG_BIG = -1e30f;

DI void softmax_tile(f32x16& p0, f32x16& p1, int kb, unsigned span, float& m, float& l, f32x16 (&o)[2]) {
    float mt = -INFINITY;
#pragma unroll
    for (int i = 0; i < 16; ++i) {
        const bool v0 = (unsigned)(kb + ci16(i)) <= span, v1 = (unsigned)(kb + 32 + ci16(i)) <= span;
        p0[i] = v0 ? p0[i] : -INFINITY; p1[i] = v1 ? p1[i] : -INFINITY;
        mt = fmaxf(mt, fmaxf(p0[i], p1[i]));
    }
    mt = fmaxf(mt, __shfl_xor(mt, 32));
    const float mn = fmaxf(m, mt);
    const float alpha = fast_exp2(m - mn);
    m = mn; l *= alpha;
#pragma unroll
    for (int i = 0; i < 16; ++i) { o[0][i] *= alpha; o[1][i] *= alpha; }
    float s = 0.f;
#pragma unroll
    for (int i = 0; i < 16; ++i) { p0[i] = fast_exp2(p0[i] - mn); p1[i] = fast_exp2(p1[i] - mn); s += p0[i] + p1[i]; }
    l += s;
}

template <int MODE>
DI void nsa_branch(LAS unsigned char* lds, const bf16_t* projb, int g, int c, int t, float slope2, float gate, const bf16x8 (&qf)[4], f32x16 (&oc)[2], int tid, int r32, int h) {
    const int colK = C_KVA + (2 + 2 * MODE) * 128 + g * 64, colV = colK + 128;
    unsigned tiles;
    unsigned selm = 0;
    if (MODE == 0) { tiles = *(const LAS unsigned*)(lds + L_UNI); selm = ((const LAS unsigned*)(lds + L_SELM))[t & 63]; }
    else { const int jlo = c - 8 < 0 ? 0 : c - 8; tiles = (0xffffffffu >> (31 - c)) & (0xffffffffu << jlo); }
    tiles = __builtin_amdgcn_readfirstlane(tiles);
    float m = NEG_BIG, l = 0.f; f32x16 o[2];
#pragma unroll
    for (int i = 0; i < 16; ++i) { o[0][i] = 0.f; o[1][i] = 0.f; }
    TileRegs tr;
    int j = __builtin_ctz(tiles); tiles &= tiles - 1;
    tile_gload(tr, projb, DINP, 64 * j, colK, colV, tid);
    int buf = 0;
    __syncthreads();
    tile_lstore(tr, lds + L_KT0, lds + L_VT0, tid);
    for (;;) {
        __syncthreads();
        const bool more = tiles != 0u; int jn = 0;
        if (more) { jn = __builtin_ctz(tiles); tiles &= tiles - 1; tile_gload(tr, projb, DINP, 64 * jn, colK, colV, tid); }
        const LAS unsigned char* kt = lds + L_KT0 + buf * TILE_B; const LAS unsigned char* vt = lds + L_VT0 + buf * TILE_B;
        const int key0 = 64 * j;
        f32x16 p0, p1;
        { const float base = slope2 * (float)(key0 + 4 * h - t);
#pragma unroll
          for (int i = 0; i < 16; ++i) { p0[i] = base; p1[i] = base; } }
        qk_tile(p0, p1, kt, qf, r32, h);
#pragma unroll
        for (int i = 0; i < 16; ++i) { p0[i] = __builtin_fmaf(slope2, (float)ci16(i), p0[i]); p1[i] = __builtin_fmaf(slope2, (float)(32 + ci16(i)), p1[i]); }
        int lo; unsigned span;
        if (MODE == 0) { lo = ((selm >> j) & 1u) ? 0 : 0x40000000; span = (unsigned)t; }
        else { lo = t - 511; span = 511u; }
        softmax_tile(p0, p1, key0 + 4 * h - lo, span, m, l, o);
        bf16x8 pf[4]; pack_p(pf, p0, p1);
        pv_tile(o, vt, pf, r32, h);
        if (!more) break;
        buf ^= 1;
        tile_lstore(tr, lds + L_KT0 + buf * TILE_B, lds + L_VT0 + buf * TILE_B, tid);
        j = jn;
    }
    l += __shfl_xor(l, 32);
    const float sc = gate / l;
    LAS float* ocl = (LAS float*)(lds + L_SLAB) + (tid >> 6) * 2048 + (tid & 63);
#pragma unroll
    for (int i = 0; i < 16; ++i) { oc[0][i] = ocl[i * 64] + o[0][i] * sc; oc[1][i] = ocl[(16 + i) * 64] + o[1][i] * sc; }
    if (MODE == 0) {
#pragma unroll
        for (int i = 0; i < 16; ++i) { ocl[i * 64] = oc[0][i]; ocl[(16 + i) * 64] = oc[1][i]; }
    }
}

DI void nsa_unit(LAS unsigned char* lds, const bf16_t* proj, const bf16_t* KC, const bf16_t* VC, bf16_t* OA, int b, int g, int c, int tid) {
    const int lane = tid & 63, w = __builtin_amdgcn_readfirstlane(tid >> 6), r32 = lane & 31, h = lane >> 5;
    const int rr = w >> 1, qh = w & 1;
    const int t = 64 * c + 32 * qh + r32;
    const bf16_t* projb = proj + (size_t)b * SEQ * DINP;
    const bf16_t* trow = projb + (size_t)t * DINP;
    bf16x8 qf[4];
#pragma unroll
    for (int ds = 0; ds < 4; ++ds) qf[ds] = *(const bf16x8*)(trow + C_QA + (g * 4 + rr) * 64 + 16 * ds + 8 * h);
    const float slope2 = exp2f(-(float)(g * 4 + rr + 1)) * LOG2E;
    const float g0 = bf2f(trow[C_GA + g * 12 + rr * 3 + 0]), g1 = bf2f(trow[C_GA + g * 12 + rr * 3 + 1]), g2 = bf2f(trow[C_GA + g * 12 + rr * 3 + 2]);
    f32x16 oc[2];
#pragma unroll
    for (int i = 0; i < 16; ++i) { oc[0][i] = 0.f; oc[1][i] = 0.f; }

    const int ntl = (c >= 16) ? 2 : 1;
    const bf16_t* kcb = KC + (size_t)(b * 2 + g) * 128 * 64; const bf16_t* vcb = VC + (size_t)(b * 2 + g) * 128 * 64;
    __syncthreads();
    for (int nt = 0; nt < ntl; ++nt) { TileRegs tr; tile_gload(tr, kcb, 64, 64 * nt, 0, 0, tid); u32x4 kk = tr.k; tile_gload(tr, vcb, 64, 64 * nt, 0, 0, tid); tr.k = kk;
        tile_lstore(tr, lds + L_KT0 + nt * TILE_B, lds + L_VT0 + nt * TILE_B, tid); }
    __syncthreads();
    {
        f32x16 pc[2][2];
        const float a16 = slope2 * 16.f;
        const int hin = (t - 31) >> 4;
        const int lo = hin < 0 ? 0x40000000 : 0; const unsigned span = hin < 0 ? 0u : (unsigned)hin;
        float mx = NEG_BIG;
#pragma unroll
        for (int nt = 0; nt < 2; ++nt) {
            if (nt < ntl) {
                const float base = a16 * (float)(64 * nt + 4 * h) + slope2 * (float)(31 - t);
#pragma unroll
                for (int i = 0; i < 16; ++i) { pc[nt][0][i] = a16 * (float)ci16(i) + base; pc[nt][1][i] = a16 * (float)(32 + ci16(i)) + base; }
                qk_tile(pc[nt][0], pc[nt][1], lds + L_KT0 + nt * TILE_B, qf, r32, h);
                const int kb = 64 * nt + 4 * h - lo;
#pragma unroll
                for (int i = 0; i < 16; ++i) {
                    const bool v0 = (unsigned)(kb + ci16(i)) <= span, v1 = (unsigned)(kb + 32 + ci16(i)) <= span;
                    pc[nt][0][i] = v0 ? pc[nt][0][i] : -INFINITY; pc[nt][1][i] = v1 ? pc[nt][1][i] : -INFINITY;
                    mx = fmaxf(mx, fmaxf(pc[nt][0][i], pc[nt][1][i]));
                }
            } else {
#pragma unroll
                for (int i = 0; i < 16; ++i) { pc[nt][0][i] = 0.f; pc[nt][1][i] = 0.f; }
            }
        }
        mx = fmaxf(mx, __shfl_xor(mx, 32));
        float ls = 0.f;
#pragma unroll
        for (int nt = 0; nt < 2; ++nt)
            if (nt < ntl) {
#pragma unroll
                for (int i = 0; i < 16; ++i) { pc[nt][0][i] = fast_exp2(pc[nt][0][i] - mx); pc[nt][1][i] = fast_exp2(pc[nt][1][i] - mx); ls += pc[nt][0][i] + pc[nt][1][i]; }
            }
        ls += __shfl_xor(ls, 32);
        const float inv = ls > 0.f ? 1.0f / ls : 0.f;
#pragma unroll
        for (int nt = 0; nt < 2; ++nt)
            if (nt < ntl) {
#pragma unroll
                for (int i = 0; i < 16; ++i) { pc[nt][0][i] *= inv; pc[nt][1][i] *= inv; }
                bf16x8 pf[4]; pack_p(pf, pc[nt][0], pc[nt][1]);
                pv_tile(oc, lds + L_VT0 + nt * TILE_B, pf, r32, h);
            }
#pragma unroll
        for (int i = 0; i < 16; ++i) { oc[0][i] *= g0; oc[1][i] *= g0; }
        LAS float* slab = (LAS float*)(lds + L_SLAB); LAS float* pcmp = (LAS float*)(lds + L_PCMP);
        const int q = 32 * qh + r32;
#pragma unroll
        for (int nt = 0; nt < 2; ++nt)
            if (nt < ntl) {
#pragma unroll
                for (int i = 0; i < 16; ++i) {
                    slab[(rr * 64 + ci16(i) + 4 * h) * 64 + q] = pc[nt][0][i];
                    slab[(rr * 64 + 32 + ci16(i) + 4 * h) * 64 + q] = pc[nt][1][i];
                }
                __syncthreads();
                { const int qq = tid & 63, ng = tid >> 6;
#pragma unroll
                  for (int e = 0; e < 8; ++e) { const int n = ng * 8 + e;
                      pcmp[(nt * 64 + n) * 64 + qq] = (slab[(0 * 64 + n) * 64 + qq] + slab[(1 * 64 + n) * 64 + qq]) + (slab[(2 * 64 + n) * 64 + qq] + slab[(3 * 64 + n) * 64 + qq]); } }
                __syncthreads();
            }
    }
    {
        const LAS float* pcmp = (const LAS float*)(lds + L_PCMP); LAS float* pslc = (LAS float*)(lds + L_PSLC);
        const int qq = tid & 63, jg = tid >> 6, nmax = 64 * ntl - 1;
#pragma unroll
        for (int e = 0; e < 4; ++e) {
            const int j = jg * 4 + e;
            if (j <= c) { float s = 0.f; const int n0 = 4 * j - 1 < 0 ? 0 : 4 * j - 1, n1 = 4 * j + 3 > nmax ? nmax : 4 * j + 3;
                for (int n = n0; n <= n1; ++n) s += pcmp[n * 64 + qq];
                pslc[j * 64 + qq] = s; }
        }
        __syncthreads();
        if (tid < 64) {
            unsigned mask;
            if (c <= 7) mask = (1u << (c + 1)) - 1u;
            else {
                mask = 1u | (1u << c) | (1u << (c - 1));
                for (int k = 0; k < 5; ++k) {
                    float bv = -1.f; int best = 1;
                    for (int j = 1; j <= c - 2; ++j) { const float v = pslc[j * 64 + tid]; const bool free_ = ((mask >> j) & 1u) == 0u; if (free_ && v > bv) { bv = v; best = j; } }
                    mask |= 1u << best;
                }
            }
            ((LAS unsigned*)(lds + L_SELM))[tid] = mask;
            unsigned un = mask;
#pragma unroll
            for (int o = 1; o < 64; o <<= 1) un |= (unsigned)__shfl_xor((int)un, o);
            if (tid == 0) *(LAS unsigned*)(lds + L_UNI) = un;
        }
        __syncthreads();
    }
    { LAS float* ocl = (LAS float*)(lds + L_SLAB) + (tid >> 6) * 2048 + (tid & 63);
#pragma unroll
      for (int i = 0; i < 16; ++i) { ocl[i * 64] = oc[0][i]; ocl[(16 + i) * 64] = oc[1][i]; } }
#ifndef NSA_NO_BR0
    nsa_branch<0>(lds, projb, g, c, t, slope2, g1, qf, oc, tid, r32, h);
#endif
#ifndef NSA_NO_BR1
    nsa_branch<1>(lds, projb, g, c, t, slope2, g2, qf, oc, tid, r32, h);
#endif
    store_ot(OA + ((size_t)b * SEQ + t) * 512 + (g * 4 + rr) * 64, oc, h);
}

DI void sb_unit(LAS unsigned char* lds, const bf16_t* proj, bf16_t* OB, int b, int hh, int qb, int tid) {
    const int lane = tid & 63, w = __builtin_amdgcn_readfirstlane(tid >> 6), r32 = lane & 31, h = lane >> 5;
    const int T0 = 256 * qb + 32 * w, t = T0 + r32;
    const bf16_t* projb = proj + (size_t)b * SEQ * DINP;
    const bf16_t* trow = projb + (size_t)t * DINP;
    bf16x8 qf[4];
#pragma unroll
    for (int ds = 0; ds < 4; ++ds) qf[ds] = *(const bf16x8*)(trow + C_QB + hh * 64 + 16 * ds + 8 * h);
    const int colK = C_KB + hh * 64, colV = C_VB + hh * 64;
    const int jw = T0 >> 6;
    f32x16 o[2];
#pragma unroll
    for (int i = 0; i < 16; ++i) { o[0][i] = 0.f; o[1][i] = 0.f; }
    float carry = 0.f;
    TileRegs tr;
    int j = 4 * qb + 3;
    tile_gload(tr, projb, DINP, 64 * j, colK, colV, tid);
    int buf = 0;
    __syncthreads();
    tile_lstore(tr, lds + L_KT0, lds + L_VT0, tid);
    for (;;) {
        __syncthreads();
        const bool more = j > 0;
        if (more) tile_gload(tr, projb, DINP, 64 * (j - 1), colK, colV, tid);
        if (j <= jw) {
            const LAS unsigned char* kt = lds + L_KT0 + buf * TILE_B; const LAS unsigned char* vt = lds + L_VT0 + buf * TILE_B;
            f32x16 p0, p1;
#pragma unroll
            for (int i = 0; i < 16; ++i) { p0[i] = 0.f; p1[i] = 0.f; }
            qk_tile(p0, p1, kt, qf, r32, h);
            const int kb = 64 * j + 4 * h - t;
            float lk[32], lsg[32];
#pragma unroll
            for (int e = 0; e < 32; ++e) {
                const float z = e < 16 ? p0[e & 15] : p1[e & 15];
                const bool valid = (kb + 32 * (e >> 4) + ci16(e & 15)) < 0;
                const float u = fast_log2(1.0f + fast_exp2(-fabsf(z)));
                lk[e] = valid ? -(fmaxf(z, 0.f) + u) : 0.f;
                lsg[e] = valid ? (fminf(z, 0.f) - u) : -INFINITY;
            }
            float gs[8], go[8];
#pragma unroll
            for (int gi = 0; gi < 8; ++gi) { gs[gi] = (lk[4 * gi] + lk[4 * gi + 1]) + (lk[4 * gi + 2] + lk[4 * gi + 3]); go[gi] = __shfl_xor(gs[gi], 32); }
            float suf = 0.f;
#pragma unroll
            for (int gi = 7; gi >= 0; --gi) {
                float later = carry + suf + (h == 0 ? go[gi] : 0.f);
                const float a3 = fast_exp2(lsg[4 * gi + 3] + later); later += lk[4 * gi + 3];
                const float a2 = fast_exp2(lsg[4 * gi + 2] + later); later += lk[4 * gi + 2];
                const float a1 = fast_exp2(lsg[4 * gi + 1] + later); later += lk[4 * gi + 1];
                const float a0 = fast_exp2(lsg[4 * gi + 0] + later);
                if (gi < 4) { p0[4 * gi] = a0; p0[4 * gi + 1] = a1; p0[4 * gi + 2] = a2; p0[4 * gi + 3] = a3; }
                else { p1[4 * gi - 16] = a0; p1[4 * gi - 15] = a1; p1[4 * gi - 14] = a2; p1[4 * gi - 13] = a3; }
                suf += gs[gi] + go[gi];
            }
            carry += suf;
            bf16x8 pf[4]; pack_p(pf, p0, p1);
            pv_tile(o, vt, pf, r32, h);
        }
        if (!more) break;
        buf ^= 1;
        tile_lstore(tr, lds + L_KT0 + buf * TILE_B, lds + L_VT0 + buf * TILE_B, tid);
        --j;
    }
    store_ot(OB + ((size_t)b * SEQ + t) * 512 + hh * 64, o, h);
}

DI float gelu_tanh(float x) {
    const float y = 0.7978845608028654f * (x + 0.044715f * x * x * x);
    const float e = fast_exp2(2.0f * LOG2E * y);
    const float th = 1.0f - 2.0f * fast_rcp(e + 1.0f);
    return 0.5f * x * (1.0f + th);
}
typedef float f32x4v __attribute__((ext_vector_type(4)));
DI void compress_unit(LAS unsigned char* lds, const bf16_t* proj, const float* pos, const bf16_t* w1t, const bf16_t* w2t, bf16_t* out, int b, int g, int kv, int nq, int tid) {
    const int lane = tid & 63, w = __builtin_amdgcn_readfirstlane(tid >> 6), l15 = lane & 15, quad = lane >> 4;
    const bf16_t* src = proj + (size_t)b * SEQ * DINP + C_KVA + kv * 128 + g * 64;
    f32x4 acc[2] = {{0.f, 0.f, 0.f, 0.f}, {0.f, 0.f, 0.f, 0.f}};
    const bf16_t* bp = w1t + (size_t)(16 * w + l15) * 2048 + quad * 8;
    for (int ks = 0; ks < 64; ++ks) {
        const int k0 = 32 * ks, l = k0 >> 6, d = (k0 & 63) + quad * 8;
        const bf16x8 bfr = *(const bf16x8*)(bp + k0);
        const f32x4 pa = *(const f32x4*)(pos + l * 64 + d), pb = *(const f32x4*)(pos + l * 64 + d + 4);
#pragma unroll
        for (int mt = 0; mt < 2; ++mt) {
            const int n = 32 * nq + 16 * mt + l15; int tok = 16 * n + l; tok = tok > SEQ - 1 ? SEQ - 1 : tok;
            const u32x4 a = *(const u32x4*)(src + (size_t)tok * DINP + d);
            u32x4 r;
            r.x = cvtpk(__uint_as_float(a.x << 16) + pa[0], __uint_as_float(a.x & 0xffff0000u) + pa[1]);
            r.y = cvtpk(__uint_as_float(a.y << 16) + pa[2], __uint_as_float(a.y & 0xffff0000u) + pa[3]);
            r.z = cvtpk(__uint_as_float(a.z << 16) + pb[0], __uint_as_float(a.z & 0xffff0000u) + pb[1]);
            r.w = cvtpk(__uint_as_float(a.w << 16) + pb[2], __uint_as_float(a.w & 0xffff0000u) + pb[3]);
            acc[mt] = __builtin_amdgcn_mfma_f32_16x16x32_bf16(__builtin_bit_cast(bf16x8, r), bfr, acc[mt], 0, 0, 0);
        }
    }
    LAS bf16_t* hid = (LAS bf16_t*)lds;
    __syncthreads();
#pragma unroll
    for (int mt = 0; mt < 2; ++mt)
#pragma unroll
        for (int jj = 0; jj < 4; ++jj) hid[(16 * mt + quad * 4 + jj) * 136 + 16 * w + l15] = (bf16_t)(cvtpk(gelu_tanh(acc[mt][jj]), 0.f) & 0xffff);
    __syncthreads();
    const int mt = w & 1, ct = w >> 1;
    f32x4 o = {0.f, 0.f, 0.f, 0.f};
#pragma unroll
    for (int ks = 0; ks < 4; ++ks) {
        const bf16x8 a = *(const LAS bf16x8*)(hid + (16 * mt + l15) * 136 + 32 * ks + quad * 8);
        const bf16x8 bb = *(const bf16x8*)(w2t + (size_t)(16 * ct + l15) * 128 + 32 * ks + quad * 8);
        o = __builtin_amdgcn_mfma_f32_16x16x32_bf16(a, bb, o, 0, 0, 0);
    }
#pragma unroll
    for (int jj = 0; jj < 4; ++jj) {
        const int n = 32 * nq + 16 * mt + quad * 4 + jj;
        out[((size_t)(b * 2 + g) * 128 + n) * 64 + 16 * ct + l15] = (bf16_t)(cvtpk(o[jj], 0.f) & 0xffff);
    }
}

struct Args {
    const float* in[20];
    float* out; unsigned char* ws;
    int ph_lo, ph_hi, coop, pad;
};
constexpr int N_PHASES = 11;

__global__ void __launch_bounds__(NTHREADS, 2) mega_fwd(Args args) {
    extern __shared__ __attribute__((aligned(16))) unsigned char lds_raw[];
    LAS unsigned char* lds = (LAS unsigned char*)lds_raw;
    const int tid = threadIdx.x, lane = tid & 63, wave = __builtin_amdgcn_readfirstlane(tid >> 6);
    const int G = gridDim.x, bx = blockIdx.x;
    const int gw = bx * NWAVES + wave, NGW = G * NWAVES;
    unsigned char* ws = args.ws;
    const float* x = args.in[0]; const float* cvec = args.in[1]; const float* w_ada = args.in[2]; const float* b_ada = args.in[3];
    const float* g_mix = args.in[4]; const float* w_in = args.in[5];
    const float* pos_k = args.in[6]; const float* cw1k = args.in[7]; const float* cw2k = args.in[8];
    const float* pos_v = args.in[9]; const float* cw1v = args.in[10]; const float* cw2v = args.in[11];
    const float* w_pa = args.in[12]; const float* w_pb = args.in[13]; const float* w_out = args.in[14];
    const float* g_ffn = args.in[15]; const float* w_gate = args.in[16]; const float* w_up = args.in[17]; const float* w_down = args.in[18];
    const float* g_fin = args.in[19];
    float* out = args.out;
    float* SUMSQ2 = (float*)(ws + WS_SUMSQ2); float* SUMSQ3 = (float*)(ws + WS_SUMSQ3);
    float* MOD = (float*)(ws + WS_MOD); float* BIASGU = (float*)(ws + WS_BIASGU);
    bf16_t* KC = (bf16_t*)(ws + WS_KC); bf16_t* VC = (bf16_t*)(ws + WS_VC);
    bf16_t* WIN = (bf16_t*)(ws + WS_WIN); bf16_t* WPA = (bf16_t*)(ws + WS_WPA); bf16_t* WPB = (bf16_t*)(ws + WS_WPB); bf16_t* WOUT = (bf16_t*)(ws + WS_WOUT);
    bf16_t* WGU = (bf16_t*)(ws + WS_WGU); bf16_t* WD = (bf16_t*)(ws + WS_WD);
    bf16_t* CW1K = (bf16_t*)(ws + WS_CW1K); bf16_t* CW1V = (bf16_t*)(ws + WS_CW1V); bf16_t* CW2K = (bf16_t*)(ws + WS_CW2K); bf16_t* CW2V = (bf16_t*)(ws + WS_CW2V);
    bf16_t* H = (bf16_t*)(ws + WS_H); bf16_t* Y = H;
    bf16_t* PROJ = (bf16_t*)(ws + WS_PROJ); bf16_t* ACT = PROJ;
    bf16_t* OA = (bf16_t*)(ws + WS_OA); bf16_t* OB = (bf16_t*)(ws + WS_OB); bf16_t* APRE = OA;

    const int lo = args.ph_lo, hi = args.ph_hi;
#ifndef SKIPMASK
#define SKIPMASK 0
#endif
#define IN(k) (lo <= (k) && (k) < hi && !((SKIPMASK >> (k)) & 1))
#define SEAM(k) do { if (IN(k) && IN((k) + 1)) { cg::this_grid().sync(); } } while (0)

    if (IN(0)) {
        for (int i = bx * NTHREADS + tid; i < 65536; i += G * NTHREADS) SUMSQ2[i] = 0.f;
        LAS float* inl = (LAS float*)lds; LAS float* red = (LAS float*)(lds + 65536);
        if (bx < 192) {
            for (int i = tid; i < 16 * 1024; i += NTHREADS) { const int k = i >> 4, b = i & 15; const float v = cvec[b * DM + k]; inl[i] = v * sigmoidf_(v); }
            __syncthreads();
            for (int u = bx; u < 192; u += G) gemv16_unit(inl, red, w_ada, 6 * DM, 32 * u, b_ada, MOD, 6 * DM, OmId(), tid);
        }
        __syncthreads();
        LAS float* scr = (LAS float*)(lds + wave * 8448);
        constexpr int I_WIN = 16 * 160, I_PA = 8 * 32, I_OUT = 16 * 32, I_G = 16 * 88, I_D = 44 * 32, I_C1 = 32 * 4, I_C2 = 2 * 2;
        constexpr int NITEMS = I_WIN + 2 * I_PA + I_OUT + 2 * I_G + I_D + 2 * I_C1 + 2 * I_C2;
        for (int it = gw; it < NITEMS; it += NGW) {
            int r = it;
            if (r < I_WIN) { transpose_item(w_in, DM, DIN, WIN, scr, r, 160, lane, MapWin()); continue; } r -= I_WIN;
            if (r < I_PA) { transpose_item(w_pa, 512, DM, WPA, scr, r, 32, lane, MapId()); continue; } r -= I_PA;
            if (r < I_PA) { transpose_item(w_pb, 512, DM, WPB, scr, r, 32, lane, MapId()); continue; } r -= I_PA;
            if (r < I_OUT) { transpose_item(w_out, DM, DM, WOUT, scr, r, 32, lane, MapId()); continue; } r -= I_OUT;
            if (r < I_G) { transpose_item(w_gate, DM, DFF, WGU, scr, r, 88, lane, MapGate()); continue; } r -= I_G;
            if (r < I_G) { transpose_item(w_up, DM, DFF, WGU, scr, r, 88, lane, MapUp()); continue; } r -= I_G;
            if (r < I_D) { transpose_item(w_down, DFF, DM, WD, scr, r, 32, lane, MapId()); continue; } r -= I_D;
            if (r < I_C1) { transpose_item(cw1k, 2048, 128, CW1K, scr, r, 4, lane, MapId()); continue; } r -= I_C1;
            if (r < I_C1) { transpose_item(cw1v, 2048, 128, CW1V, scr, r, 4, lane, MapId()); continue; } r -= I_C1;
            if (r < I_C2) { transpose_item(cw2k, 128, 64, CW2K, scr, r, 2, lane, MapId()); continue; } r -= I_C2;
            transpose_item(cw2v, 128, 64, CW2V, scr, r, 2, lane, MapId());
        }
    }
    SEAM(0);
    if (IN(1)) {
        if (bx < 176) {
            LAS float* inl = (LAS float*)lds; LAS float* red = (LAS float*)(lds + 65536);
            __syncthreads();
            for (int i = tid; i < 16 * 1024; i += NTHREADS) { const int k = i >> 4, b = i & 15; inl[i] = MOD[b * 6144 + 3 * DM + k]; }
            __syncthreads();
            for (int u = bx; u < 176; u += G) {
                if (u < 88) gemv16_unit(inl, red, w_gate, DFF, 32 * u, (const float*)nullptr, BIASGU, DGU, OmGate(), tid);
                else gemv16_unit(inl, red, w_up, DFF, 32 * (u - 88), (const float*)nullptr, BIASGU, DGU, OmUp(), tid);
            }
        }
        for (int m = gw; m < MT; m += NGW) {
            const int b = m >> 11;
            const f32x4* xr = (const f32x4*)(x + (size_t)m * DM) + lane;
            f32x4 v[4]; float s = 0.f;
#pragma unroll
            for (int j = 0; j < 4; ++j) { v[j] = xr[64 * j]; s += (v[j][0] * v[j][0] + v[j][1] * v[j][1]) + (v[j][2] * v[j][2] + v[j][3] * v[j][3]); }
            const float rstd = 1.0f / sqrtf(wave_sum(s) * (1.0f / DM) + RMS_EPS);
            u32x2* o8 = (u32x2*)(H + (size_t)m * DM) + lane;
#pragma unroll
            for (int j = 0; j < 4; ++j) {
                const int col = 4 * lane + 256 * j;
                const f32x4 gg = *(const f32x4*)(g_mix + col), sh = *(const f32x4*)(MOD + b * 6144 + col), sc = *(const f32x4*)(MOD + b * 6144 + DM + col);
                const f32x4 r = v[j] * rstd * gg * (sc + 1.0f) + sh;
                u32x2 w; w.x = cvtpk(r[0], r[1]); w.y = cvtpk(r[2], r[3]);
                o8[64 * j] = w;
            }
        }
    }
    SEAM(1);
    if (IN(2)) {
        __syncthreads();
        pg8::Gemm g{H, WIN, MT, DINP, DM}; pg8::StaticOrder S; S.init(MT, DINP, G, bx);
        EpiProj E{PROJ};
        pg8::gemm_phase<EpiProj, pg8::StaticOrder, true, true>(lds, g, S, E);
    }
    SEAM(2);
    if (IN(3)) {
        __syncthreads();
        for (int u = bx; u < 256; u += G) {
            const int kv = u & 1, nq = (u >> 1) & 3, g = (u >> 3) & 1, b = u >> 4;
            compress_unit(lds, PROJ, kv ? pos_v : pos_k, kv ? CW1V : CW1K, kv ? CW2V : CW2K, kv ? VC : KC, b, g, kv, nq, tid);
        }
    }
    SEAM(3);
    if (IN(4)) {
        __syncthreads();
        for (int u = bx; u < 1024; u += G) {
            const int wgi = u & 255, rnd = u >> 8, bg = wgi & 31, s = wgi >> 5;
            const int c = rnd == 0 ? s : rnd == 1 ? 15 - s : rnd == 2 ? 16 + s : 31 - s;
#ifndef SKIP_NSA
            nsa_unit(lds, PROJ, KC, VC, OA, bg >> 1, bg & 1, c, tid);
#endif
        }
        for (int u = bx; u < 1024; u += G) {
            const int wgi = u & 255, rnd = u >> 8, bh = wgi >> 1, half = wgi & 1;
            const int qb = half == 0 ? (rnd == 0 ? 0 : rnd == 1 ? 7 : rnd == 2 ? 1 : 6) : (rnd == 0 ? 2 : rnd == 1 ? 5 : rnd == 2 ? 3 : 4);
#ifndef SKIP_SB
            sb_unit(lds, PROJ, OB, bh >> 3, bh & 7, qb, tid);
#endif
        }
    }
    SEAM(4);
    if (IN(5)) {
        __syncthreads();
        pg8::Gemm g{OA, WPA, MT, DM, 512}; pg8::StaticOrder S; S.init(MT, DM, G, bx);
        EpiMerge<0> E{PROJ, Y};
        pg8::gemm_phase<EpiMerge<0>, pg8::StaticOrder, true, true>(lds, g, S, E);
    }
    if (IN(6)) {
        __syncthreads();
        pg8::Gemm g{OB, WPB, MT, DM, 512}; pg8::StaticOrder S; S.init(MT, DM, G, bx);
        EpiMerge<1> E{PROJ, Y};
        pg8::gemm_phase<EpiMerge<1>, pg8::StaticOrder, true, true>(lds, g, S, E);
    }
    SEAM(6);
    if (IN(7)) {
        __syncthreads();
        pg8::Gemm g{Y, WOUT, MT, DM, DM}; pg8::StaticOrder S; S.init(MT, DM, G, bx);
        EpiOut E{x, out, APRE, MOD, g_ffn, SUMSQ2};
        pg8::gemm_phase<EpiOut, pg8::StaticOrder, true, true>(lds, g, S, E);
    }
    SEAM(7);
    if (IN(8)) {
        __syncthreads();
        pg8::Gemm g{APRE, WGU, MT, DGU, DM}; pg8::StaticOrder S; S.init(MT, DGU, G, bx);
        EpiGU E{SUMSQ2, BIASGU, ACT};
        pg8::gemm_phase<EpiGU, pg8::StaticOrder, true, true>(lds, g, S, E);
    }
    SEAM(8);
    if (IN(9)) {
        __syncthreads();
        pg8::Gemm g{ACT, WD, MT, DM, DFF}; pg8::StaticOrder S; S.init(MT, DM, G, bx);
        EpiDown E{out, MOD, SUMSQ3};
        pg8::gemm_phase<EpiDown, pg8::StaticOrder, true, true>(lds, g, S, E);
    }
    SEAM(9);
    if (IN(10)) {
        for (int m = gw; m < MT; m += NGW) {
            const float rstd = 1.0f / sqrtf(SUMSQ3[m] * (1.0f / DM) + RMS_EPS);
            f32x4* xr = (f32x4*)(out + (size_t)m * DM) + lane;
#pragma unroll
            for (int j = 0; j < 4; ++j) { const f32x4 gg = *(const f32x4*)(g_fin + 4 * lane + 256 * j); xr[64 * j] = xr[64 * j] * rstd * gg; }
        }
    }
#undef IN
#undef SEAM
}

#ifndef MK_N_LAUNCHES
#define MK_N_LAUNCHES 1
#endif

extern "C" void kernel_launch(void* const* d_in, const int* in_sizes, int n_in, void* d_out, int out_size, void* d_ws, size_t ws_size, hipStream_t stream) {
    static int grid = 0;
    if (grid == 0) {
        if (n_in != 20 || out_size != MT * DM || ws_size < WS_END) { fprintf(stderr, "kernel_launch: unexpected shapes n_in %d out %d ws %zu\n", n_in, out_size, ws_size); grid = -1; return; }
        int dev = 0, cus = 0, per_cu = 0;
        hipGetDevice(&dev);
        hipDeviceGetAttribute(&cus, hipDeviceAttributeMultiprocessorCount, dev);
        if (hipFuncSetAttribute((const void*)mega_fwd, hipFuncAttributeMaxDynamicSharedMemorySize, LDS_BYTES) != hipSuccess) { fprintf(stderr, "kernel_launch: hipFuncSetAttribute failed\n"); grid = -1; return; }
        if (hipOccupancyMaxActiveBlocksPerMultiprocessor(&per_cu, (const void*)mega_fwd, NTHREADS, LDS_BYTES) != hipSuccess || per_cu < 1) { fprintf(stderr, "kernel_launch: occupancy query gave %d\n", per_cu); per_cu = 1; }
        (void)hipGetLastError();
        grid = cus * 1;
        if (grid <= 0) grid = 256;
    }
    if (grid < 0) return;
    Args a{};
    for (int i = 0; i < 20; ++i) a.in[i] = (const float*)d_in[i];
    a.out = (float*)d_out; a.ws = (unsigned char*)d_ws;
#if MK_N_LAUNCHES == 1
    a.ph_lo = 0; a.ph_hi = N_PHASES; a.coop = 1; a.pad = 0;
    void* kargs[] = {&a};
    hipError_t e = hipLaunchCooperativeKernel((const void*)mega_fwd, dim3(grid), dim3(NTHREADS), kargs, LDS_BYTES, stream);
    if (e != hipSuccess) fprintf(stderr, "kernel_launch: cooperative launch failed: %s (grid %d)\n", hipGetErrorString(e), grid);
#else
    const int cuts[] = {0, 1, 2, 3, 4, 5, 7, 8, 9, 10, 11};
    for (int li = 0; li + 1 < (int)(sizeof(cuts) / sizeof(int)); ++li) {
        a.ph_lo = cuts[li]; a.ph_hi = cuts[li + 1]; a.coop = 0; a.pad = 0;
        hipLaunchKernelGGL(mega_fwd, dim3(grid), dim3(NTHREADS), LDS_BYTES, stream, a);
    }
#endif
}
```

```cpp
#include <hip/hip_runtime.h>
#include <hip/hip_cooperative_groups.h>
#include <cstdio>
#include <cstdint>
#include <cmath>
namespace cg = cooperative_groups;
namespace pg8 {
#define PG8_LAS __attribute__((address_space(3)))
typedef unsigned short bf16_t;
typedef short bf16x8 __attribute__((ext_vector_type(8)));
typedef float f32x4 __attribute__((ext_vector_type(4)));
typedef unsigned u32x4 __attribute__((ext_vector_type(4)));
constexpr int BM = 256, BK = 64, HALF = 128, HTB = HALF * BK * 2  , STAGE_BYTES = 8 * HTB, NXCD = 8, WGM = 8;

__host__ __device__ __forceinline__ int lds_byte(int r, int c) { const int st = (r >> 4) * 2 + (c >> 5), rr = r & 15, cc = c & 31, ob = rr * 64 + cc * 2; return st * 1024 + (ob ^ (((ob >> 9) & 1) << 5)); }
__host__ __device__ __forceinline__ void stage_rc(int b, int& R, int& C) { const int st = b / 1024, sb = b % 1024, swz = sb ^ (((sb >> 9) & 1) << 5); R = (st >> 1) * 16 + swz / 64; C = (st & 1) * 32 + (swz % 64) / 2; }
__host__ __device__ __forceinline__ int perm32(int rho) { const int n = rho >> 4, i = rho & 15; return 8 * (i >> 2) + 4 * n + (i & 3); }

struct Unit { int pm, pn; };
struct Gemm { const bf16_t* A; const bf16_t* Bt; int M, N, K; };

struct StaticOrder {
    int nM, nN, nwg, G, c;
    __host__ __device__ void init(int M, int N, int G_, int c_) { nM = M / BM; nN = N / BM; nwg = nM * nN; G = G_; c = c_; }
    __host__ __device__ bool next(int i, Unit& u) const {
        const long L = (long)i * G + c; if (L >= nwg) return false;
        int wgid = (int)L; { const int q = nwg / NXCD, r = nwg % NXCD, xcd = wgid % NXCD, off = wgid / NXCD; wgid = (xcd < r ? xcd * (q + 1) : r * (q + 1) + (xcd - r) * q) + off; }
        const int nig = WGM * nN, gid = wgid / nig, fm = gid * WGM, gsz = (nM - fm) < WGM ? (nM - fm) : WGM;
        u.pm = fm + ((wgid % nig) % gsz); u.pn = (wgid % nig) / gsz; return true;
    }
    __device__ __forceinline__ void a_ready(const Unit&) const {}
    __device__ __forceinline__ void done(const Unit&) const {}
};

__device__ __forceinline__ unsigned cvt_pk_bf16(float lo, float hi) { unsigned r; asm volatile("v_cvt_pk_bf16_f32 %0, %1, %2" : "=v"(r) : "v"(lo), "v"(hi)); return r; }
template <class Epi, class Sched, bool ALIGN_EPI = false, bool SP2 = false>
__device__ __forceinline__ void gemm_phase(PG8_LAS unsigned char* lds, const Gemm g, const Sched& S, const Epi& E) {
    const int tid = threadIdx.x, wid = __builtin_amdgcn_readfirstlane(tid >> 6), lane = tid & 63, wr = wid >> 2, wc = wid & 3, fr = lane & 15, fq = lane >> 4;
    const int K = g.K, nt = K / BK;
    unsigned voffA[2], voffB[2];
#pragma unroll
    for (int i = 0; i < 2; ++i) { int R, C; stage_rc(tid * 16 + i * 8192, R, C); const int Rb = Epi::PERM ? ((R & ~31) + perm32(R & 31)) : R;
        voffA[i] = (unsigned)(R * K + C) * 2u; voffB[i] = (unsigned)(Rb * K + C) * 2u; }
    const size_t kstep = (size_t)(BK * 2);
    const size_t hstep = (size_t)HALF * K * 2;
    const size_t tstep = 2 * hstep;
    const unsigned ldsw = (unsigned)wid * 1024u;
    const int aoff = lds_byte(wr * 64 + fr, fq * 8), boff = lds_byte(wc * 32 + fr, fq * 8);
#define PG8_SA(b, h) (((b) * 2 + (h)) * HTB)
#define PG8_SB(b, h) ((4 + (b) * 2 + (h)) * HTB)
#define PG8_STAGE(bufoff, gbase, voff) do { _Pragma("unroll") for (int _i = 0; _i < 2; ++_i) \
        __builtin_amdgcn_global_load_lds((const unsigned*)((const char*)(gbase) + (voff)[_i]), (PG8_LAS unsigned*)(lds + (bufoff) + ldsw + _i * 8192), 16, 0, 0); } while (0)
#define PG8_LDA(dst, b, h) do { _Pragma("unroll") for (int m = 0; m < 4; ++m) _Pragma("unroll") for (int k = 0; k < 2; ++k) dst[m][k] = *(const PG8_LAS bf16x8*)(lds + PG8_SA(b, h) + aoff + m * 2048 + k * 1024); } while (0)
#define PG8_LDB(dst, b, h) do { _Pragma("unroll") for (int n = 0; n < 2; ++n) _Pragma("unroll") for (int k = 0; k < 2; ++k) dst[n][k] = *(const PG8_LAS bf16x8*)(lds + PG8_SB(b, h) + boff + n * 2048 + k * 1024); } while (0)
#define PG8_MMA(ai, bj, At, Bt) do { __builtin_amdgcn_s_setprio(1); _Pragma("unroll") for (int m = 0; m < 4; ++m) _Pragma("unroll") for (int n = 0; n < 2; ++n) _Pragma("unroll") for (int k = 0; k < 2; ++k) \
        acc[ai][bj][m][n] = __builtin_amdgcn_mfma_f32_16x16x32_bf16(Bt[n][k], At[m][k], acc[ai][bj][m][n], 0, 0, 0); __builtin_amdgcn_s_setprio(0); } while (0)
#define PG8_WAIT_V(n) asm volatile("s_waitcnt vmcnt(" #n ")" ::: "memory")
#define PG8_WAIT_L(n) asm volatile("s_waitcnt lgkmcnt(" #n ")" ::: "memory")
#define PG8_BAR __builtin_amdgcn_s_barrier()
#define PG8_SCHED __builtin_amdgcn_sched_barrier(0)
    Unit cur, nxt; int ui = 0;
    if (!S.next(0, cur)) return;
    f32x4 acc[2][2][4][2];
#pragma unroll
    for (int a = 0; a < 2; ++a)
#pragma unroll
        for (int b = 0; b < 2; ++b)
#pragma unroll
            for (int m = 0; m < 4; ++m)
#pragma unroll
                for (int n = 0; n < 2; ++n) acc[a][b][m][n] = (f32x4){0.f, 0.f, 0.f, 0.f};
    bf16x8 At[4][2], B0[2][2], B1[2][2];
    const char* cA = (const char*)g.A + (size_t)cur.pm * tstep; const char* cB = (const char*)g.Bt + (size_t)cur.pn * tstep;
    S.a_ready(cur);
    if constexpr (SP2) {
        PG8_STAGE(PG8_SB(0, 0), cB, voffB); PG8_STAGE(PG8_SB(0, 1), cB + hstep, voffB); PG8_STAGE(PG8_SA(0, 0), cA, voffA); PG8_STAGE(PG8_SA(0, 1), cA + hstep, voffA);
        if (wr == 1) PG8_BAR;
        PG8_WAIT_V(2); PG8_BAR;
        PG8_STAGE(PG8_SB(1, 0), cB + kstep, voffB); PG8_STAGE(PG8_SA(1, 0), cA + kstep, voffA); PG8_STAGE(PG8_SB(1, 1), cB + hstep + kstep, voffB);
        PG8_WAIT_V(6); PG8_BAR;
    } else {
        PG8_STAGE(PG8_SB(0, 0), cB, voffB); PG8_STAGE(PG8_SA(0, 0), cA, voffA); PG8_STAGE(PG8_SB(0, 1), cB + hstep, voffB); PG8_STAGE(PG8_SA(0, 1), cA + hstep, voffA);
        if (wr == 1) PG8_BAR;
        PG8_WAIT_V(4); PG8_BAR;
        PG8_STAGE(PG8_SB(1, 0), cB + kstep, voffB); PG8_STAGE(PG8_SA(1, 0), cA + kstep, voffA); PG8_STAGE(PG8_SB(1, 1), cB + hstep + kstep, voffB);
        PG8_WAIT_V(6); PG8_BAR;
    }
    for (;;) {
        const bool has_next = S.next(ui + 1, nxt);
        const char* nA = has_next ? (const char*)g.A + (size_t)nxt.pm * tstep : cA; const char* nB = has_next ? (const char*)g.Bt + (size_t)nxt.pn * tstep : cB;
        for (int t = 0; t < nt; t += 2) {
            const bool last = (t == nt - 2);
            const char* a1 = cA + (size_t)(t + 1) * kstep;
            const char* a2 = last ? nA : cA + (size_t)(t + 2) * kstep; const char* b2 = last ? nB : cB + (size_t)(t + 2) * kstep;
            const char* a3 = a2 + kstep; const char* b3 = b2 + kstep;
            if (last && has_next) S.a_ready(nxt);
            if constexpr (SP2) {
            PG8_LDB(B0, 0, 0); PG8_LDB(B1, 0, 1); PG8_SCHED; PG8_LDA(At, 0, 0); PG8_STAGE(PG8_SA(1, 1), a1 + hstep, voffA);
            PG8_WAIT_V(8); PG8_WAIT_L(0); PG8_BAR; PG8_MMA(0, 0, At, B0); PG8_MMA(0, 1, At, B1); PG8_BAR; PG8_SCHED;
            PG8_LDA(At, 0, 1); PG8_STAGE(PG8_SB(0, 0), b2, voffB); PG8_STAGE(PG8_SB(0, 1), b2 + hstep, voffB); PG8_STAGE(PG8_SA(0, 0), a2, voffA);
            PG8_WAIT_V(8); PG8_WAIT_L(0); PG8_BAR; PG8_MMA(1, 0, At, B0); PG8_MMA(1, 1, At, B1); PG8_BAR; PG8_SCHED;
            PG8_LDB(B0, 1, 0); PG8_LDB(B1, 1, 1); PG8_SCHED; PG8_LDA(At, 1, 0); PG8_STAGE(PG8_SA(0, 1), a2 + hstep, voffA);
            PG8_WAIT_V(8); PG8_WAIT_L(0); PG8_BAR; PG8_MMA(0, 0, At, B0); PG8_MMA(0, 1, At, B1); PG8_BAR; PG8_SCHED;
            PG8_LDA(At, 1, 1); PG8_STAGE(PG8_SB(1, 0), b3, voffB); PG8_STAGE(PG8_SB(1, 1), b3 + hstep, voffB); PG8_STAGE(PG8_SA(1, 0), a3, voffA);
            PG8_WAIT_V(8); PG8_WAIT_L(0); PG8_BAR; PG8_MMA(1, 0, At, B0); PG8_MMA(1, 1, At, B1); PG8_BAR; PG8_SCHED;
            } else {
            PG8_LDB(B0, 0, 0); PG8_SCHED; PG8_LDA(At, 0, 0); PG8_STAGE(PG8_SA(1, 1), a1 + hstep, voffA);
            PG8_WAIT_L(8); PG8_BAR; PG8_WAIT_L(0); PG8_MMA(0, 0, At, B0); PG8_BAR; PG8_SCHED;
            PG8_LDB(B1, 0, 1); PG8_STAGE(PG8_SB(0, 0), b2, voffB);
            PG8_BAR; PG8_WAIT_L(0); PG8_MMA(0, 1, At, B1); PG8_BAR;
            PG8_LDA(At, 0, 1); PG8_STAGE(PG8_SA(0, 0), a2, voffA);
            PG8_BAR; PG8_WAIT_L(0); PG8_MMA(1, 0, At, B0); PG8_BAR; PG8_SCHED;
            PG8_STAGE(PG8_SB(0, 1), b2 + hstep, voffB);
            PG8_WAIT_V(6); PG8_BAR; PG8_MMA(1, 1, At, B1); PG8_BAR;
            PG8_LDB(B0, 1, 0); PG8_SCHED; PG8_LDA(At, 1, 0); PG8_STAGE(PG8_SA(0, 1), a2 + hstep, voffA);
            PG8_WAIT_L(8); PG8_BAR; PG8_WAIT_L(0); PG8_MMA(0, 0, At, B0); PG8_BAR; PG8_SCHED;
            PG8_LDB(B1, 1, 1); PG8_STAGE(PG8_SB(1, 0), b3, voffB);
            PG8_BAR; PG8_WAIT_L(0); PG8_MMA(0, 1, At, B1); PG8_BAR;
            PG8_LDA(At, 1, 1); PG8_STAGE(PG8_SA(1, 0), a3, voffA);
            PG8_BAR; PG8_WAIT_L(0); PG8_MMA(1, 0, At, B0); PG8_BAR; PG8_SCHED;
            PG8_STAGE(PG8_SB(1, 1), b3 + hstep, voffB);
            PG8_WAIT_V(6); PG8_BAR; PG8_MMA(1, 1, At, B1); PG8_BAR;
            }
        }
        if constexpr (ALIGN_EPI) { if (wr == 0) PG8_BAR; }
        if constexpr (!Epi::AFTER_DRAIN) { E(acc, cur, wr, wc, fr, fq); S.done(cur); }
        if (!has_next) break;
#pragma unroll
        for (int a = 0; a < 2; ++a)
#pragma unroll
            for (int b = 0; b < 2; ++b)
#pragma unroll
                for (int m = 0; m < 4; ++m)
#pragma unroll
                    for (int n = 0; n < 2; ++n) acc[a][b][m][n] = (f32x4){0.f, 0.f, 0.f, 0.f};
        cur = nxt; cA = nA; cB = nB; ++ui;
        if constexpr (ALIGN_EPI) { if (wr == 1) PG8_BAR; }
    }
    PG8_WAIT_V(0);
    if constexpr (!ALIGN_EPI) { if (wr == 0) PG8_BAR; }
    PG8_BAR;
    if constexpr (Epi::AFTER_DRAIN) { E.fused(acc, cur, wr, wc, fr, fq, lds, wid, lane); S.done(cur); }
#undef PG8_SA
#undef PG8_SB
#undef PG8_STAGE
#undef PG8_LDA
#undef PG8_LDB
#undef PG8_MMA
#undef PG8_WAIT_V
#undef PG8_WAIT_L
#undef PG8_BAR
#undef PG8_SCHED
}
}

#define LAS __attribute__((address_space(3)))
#define DI __device__ __forceinline__
typedef unsigned short bf16_t;
typedef short bf16x8 __attribute__((ext_vector_type(8)));
typedef float f32x4 __attribute__((ext_vector_type(4)));
typedef float f32x16 __attribute__((ext_vector_type(16)));
typedef unsigned u32x4 __attribute__((ext_vector_type(4)));
typedef unsigned u32x2 __attribute__((ext_vector_type(2)));
typedef float f32x2_t __attribute__((ext_vector_type(2)));
typedef __bf16 bf16x2_t __attribute__((ext_vector_type(2)));

constexpr int NB = 16, SEQ = 2048, DM = 1024, MT = NB * SEQ;
constexpr int DIN = 4888, DINP = 5120, DFF = 2816, DGU = 2 * DFF;
constexpr int C_QA = 0, C_KVA = 512, C_GA = 1280, C_QB = 1304, C_KB = 1816, C_VB = 2328, C_MG = 2840;
constexpr float LOG2E = 1.4426950408889634f;
constexpr float QSCALE = 0.125f * LOG2E;
constexpr float RMS_EPS = 1e-6f;
constexpr int NWAVES = 8, NTHREADS = 512;
constexpr int LDS_BYTES = 147456;

constexpr size_t MiB = 1u << 20;
constexpr size_t WS_SUMSQ2 = 0, WS_SUMSQ3 = 128 * 1024, WS_MOD = 256 * 1024, WS_BIASGU = 1 * MiB, WS_KC = 2 * MiB, WS_VC = 2 * MiB + 512 * 1024;
constexpr size_t WS_WIN = 4 * MiB, WS_WPA = 14 * MiB, WS_WPB = 15 * MiB, WS_WOUT = 16 * MiB, WS_WGU = 18 * MiB, WS_WD = 29 * MiB;
constexpr size_t WS_CW1K = 35 * MiB, WS_CW1V = 35 * MiB + 512 * 1024, WS_CW2K = 36 * MiB, WS_CW2V = 36 * MiB + 64 * 1024;
constexpr size_t WS_H = 40 * MiB;
constexpr size_t WS_PROJ = 104 * MiB;
constexpr size_t WS_OA = 424 * MiB, WS_OB = 456 * MiB;
constexpr size_t WS_END = 488 * MiB;

DI float bf2f(unsigned short v) { return __uint_as_float((unsigned)v << 16); }
DI unsigned cvtpk(float lo, float hi) { f32x2_t v = {lo, hi}; bf16x2_t b = __builtin_convertvector(v, bf16x2_t); return __builtin_bit_cast(unsigned, b); }
DI float fast_exp2(float x) { return __builtin_amdgcn_exp2f(x); }
DI float fast_log2(float x) { return __builtin_amdgcn_logf(x); }
DI float fast_rcp(float x) { return __builtin_amdgcn_rcpf(x); }
DI float sigmoidf_(float x) { return fast_rcp(1.0f + fast_exp2(-x * LOG2E)); }
DI float wave_sum(float v) {
#pragma unroll
    for (int o = 1; o < 64; o <<= 1) v += __shfl_xor(v, o);
    return v;
}
#define LDS_WAIT() asm volatile("s_waitcnt lgkmcnt(0)" ::: "memory")

using pg8::Unit;
struct EpiProj {
    static constexpr bool PERM = true, AFTER_DRAIN = false;
    bf16_t* O;
    DI void operator()(const f32x4 (&acc)[2][2][4][2], const Unit& u, int wr, int wc, int fr, int fq) const {
        const int row0 = u.pm * 256 + wr * 64 + fr, colb = u.pn * 256 + wc * 32 + 8 * fq;
#pragma unroll
        for (int ai = 0; ai < 2; ++ai)
#pragma unroll
            for (int m = 0; m < 4; ++m) {
                bf16_t* rowp = O + (size_t)(row0 + ai * 128 + m * 16) * DINP + colb;
#pragma unroll
                for (int bj = 0; bj < 2; ++bj) {
                    const int col = colb + bj * 128;
                    const bool sg = (col >= C_GA && col < C_QB) || (col >= C_MG);
                    f32x4 v0 = acc[ai][bj][m][0], v1 = acc[ai][bj][m][1];
                    if (sg) {
#pragma unroll
                        for (int e = 0; e < 4; ++e) { v0[e] = sigmoidf_(v0[e]); v1[e] = sigmoidf_(v1[e]); }
                    }
                    u32x4 w; w.x = cvtpk(v0[0], v0[1]); w.y = cvtpk(v0[2], v0[3]); w.z = cvtpk(v1[0], v1[1]); w.w = cvtpk(v1[2], v1[3]);
                    *(u32x4*)(rowp + bj * 128) = w;
                }
            }
    }
};
template <int PASS> struct EpiMerge {
    static constexpr bool PERM = true, AFTER_DRAIN = false;
    const bf16_t* __restrict__ proj; bf16_t* Y;
    DI void operator()(const f32x4 (&acc)[2][2][4][2], const Unit& u, int wr, int wc, int fr, int fq) const {
        const int row0 = u.pm * 256 + wr * 64 + fr, colb = u.pn * 256 + wc * 32 + 8 * fq;
#pragma unroll
        for (int ai = 0; ai < 2; ++ai) {
            u32x4 mg[4][2], pv[4][2];
#pragma unroll
            for (int m = 0; m < 4; ++m)
#pragma unroll
                for (int bj = 0; bj < 2; ++bj) {
                    const size_t row = (size_t)(row0 + ai * 128 + m * 16); const int col = colb + bj * 128;
                    mg[m][bj] = __builtin_nontemporal_load((const u32x4*)(proj + row * DINP + C_MG + PASS * DM + col));
                    if (PASS == 1) pv[m][bj] = *(const u32x4*)(Y + row * DM + col);
                }
#pragma unroll
            for (int m = 0; m < 4; ++m)
#pragma unroll
                for (int bj = 0; bj < 2; ++bj) {
                    const size_t row = (size_t)(row0 + ai * 128 + m * 16); const int col = colb + bj * 128;
                    const u32x4 g = mg[m][bj];
                    f32x4 v0 = acc[ai][bj][m][0], v1 = acc[ai][bj][m][1];
                    v0[0] *= __uint_as_float(g.x << 16); v0[1] *= __uint_as_float(g.x & 0xffff0000u);
                    v0[2] *= __uint_as_float(g.y << 16); v0[3] *= __uint_as_float(g.y & 0xffff0000u);
                    v1[0] *= __uint_as_float(g.z << 16); v1[1] *= __uint_as_float(g.z & 0xffff0000u);
                    v1[2] *= __uint_as_float(g.w << 16); v1[3] *= __uint_as_float(g.w & 0xffff0000u);
                    if (PASS == 1) {
                        const u32x4 q = pv[m][bj];
                        v0[0] += __uint_as_float(q.x << 16); v0[1] += __uint_as_float(q.x & 0xffff0000u);
                        v0[2] += __uint_as_float(q.y << 16); v0[3] += __uint_as_float(q.y & 0xffff0000u);
                        v1[0] += __uint_as_float(q.z << 16); v1[1] += __uint_as_float(q.z & 0xffff0000u);
                        v1[2] += __uint_as_float(q.w << 16); v1[3] += __uint_as_float(q.w & 0xffff0000u);
                    }
                    u32x4 w; w.x = cvtpk(v0[0], v0[1]); w.y = cvtpk(v0[2], v0[3]); w.z = cvtpk(v1[0], v1[1]); w.w = cvtpk(v1[2], v1[3]);
                    *(u32x4*)(Y + row * DM + col) = w;
                }
        }
    }
};
struct EpiOut {
    static constexpr bool PERM = false, AFTER_DRAIN = false;
    const float* x; bf16_t* x1; bf16_t* apre; const float* mod; const float* gffn; float* sumsq;
    DI void operator()(const f32x4 (&acc)[2][2][4][2], const Unit& u, int wr, int wc, int fr, int fq) const {
        const int b = u.pm >> 3, colb = u.pn * 256 + wc * 32 + 4 * fq;
        f32x4 g1v[2][2], mul[2][2];
#pragma unroll
        for (int bj = 0; bj < 2; ++bj)
#pragma unroll
            for (int n = 0; n < 2; ++n) {
                const int col = colb + bj * 128 + n * 16;
                g1v[bj][n] = *(const f32x4*)(mod + b * 6144 + 2 * DM + col);
                const f32x4 sc = *(const f32x4*)(mod + b * 6144 + 4 * DM + col), gg = *(const f32x4*)(gffn + col);
                mul[bj][n] = gg * (sc + 1.0f);
            }
#pragma unroll
        for (int ai = 0; ai < 2; ++ai)
#pragma unroll
          for (int mh = 0; mh < 2; ++mh) {
            f32x4 xin[2][2][2];
#pragma unroll
            for (int mm = 0; mm < 2; ++mm)
#pragma unroll
                for (int bj = 0; bj < 2; ++bj)
#pragma unroll
                    for (int n = 0; n < 2; ++n) xin[mm][bj][n] = __builtin_nontemporal_load((const f32x4*)(x + (size_t)(u.pm * 256 + ai * 128 + wr * 64 + (2 * mh + mm) * 16 + fr) * DM + colb + bj * 128 + n * 16));
#pragma unroll
            for (int mm = 0; mm < 2; ++mm) {
                const int m = 2 * mh + mm;
                const size_t row = (size_t)(u.pm * 256 + ai * 128 + wr * 64 + m * 16 + fr);
                float ss = 0.f;
#pragma unroll
                for (int bj = 0; bj < 2; ++bj)
#pragma unroll
                    for (int n = 0; n < 2; ++n) {
                        const size_t off = row * DM + colb + bj * 128 + n * 16;
                        const f32x4 xv = xin[mm][bj][n];
                        const f32x4 v = xv + g1v[bj][n] * acc[ai][bj][m][n];
                        { u32x2 wv; wv.x = cvtpk(v[0], v[1]); wv.y = cvtpk(v[2], v[3]); *(u32x2*)(x1 + off) = wv; }
                        ss += (v[0] * v[0] + v[1] * v[1]) + (v[2] * v[2] + v[3] * v[3]);
                        const f32x4 a = v * mul[bj][n];
                        u32x2 w; w.x = cvtpk(a[0], a[1]); w.y = cvtpk(a[2], a[3]);
                        *(u32x2*)(apre + off) = w;
                    }
                ss += __shfl_xor(ss, 16); ss += __shfl_xor(ss, 32);
                if (fq == 0) atomicAdd(sumsq + row, ss);
            }
          }
    }
};
struct EpiGU {
    static constexpr bool PERM = true, AFTER_DRAIN = false;
    const float* sumsq; const float* biasgu; bf16_t* act;
    DI void operator()(const f32x4 (&acc)[2][2][4][2], const Unit& u, int wr, int wc, int fr, int fq) const {
        const int b = u.pm >> 3, colb = u.pn * 256 + wc * 32 + 8 * fq;
        f32x4 bg[2], bu[2];
#pragma unroll
        for (int bj = 0; bj < 2; ++bj) { bg[bj] = *(const f32x4*)(biasgu + b * DGU + colb + bj * 128); bu[bj] = *(const f32x4*)(biasgu + b * DGU + colb + bj * 128 + 4); }
#pragma unroll
        for (int ai = 0; ai < 2; ++ai)
#pragma unroll
            for (int m = 0; m < 4; ++m) {
                const size_t row = (size_t)(u.pm * 256 + ai * 128 + wr * 64 + m * 16 + fr);
                const float rstd = 1.0f / sqrtf(sumsq[row] * (1.0f / DM) + RMS_EPS);
#pragma unroll
                for (int bj = 0; bj < 2; ++bj) {
                    const f32x4 gv = acc[ai][bj][m][0] * rstd + bg[bj], uv = acc[ai][bj][m][1] * rstd + bu[bj];
                    float a[4];
#pragma unroll
                    for (int e = 0; e < 4; ++e) a[e] = gv[e] * sigmoidf_(gv[e]) * uv[e];
                    u32x2 w; w.x = cvtpk(a[0], a[1]); w.y = cvtpk(a[2], a[3]);
                    *(u32x2*)(act + row * DFF + ((colb + bj * 128) >> 1)) = w;
                }
            }
    }
};
struct EpiDown {
    static constexpr bool PERM = false, AFTER_DRAIN = false;
    const bf16_t* xio; bf16_t* xout; const float* mod; float* sumsq;
    DI void operator()(const f32x4 (&acc)[2][2][4][2], const Unit& u, int wr, int wc, int fr, int fq) const {
        const int b = u.pm >> 3, colb = u.pn * 256 + wc * 32 + 4 * fq;
        f32x4 g2v[2][2];
#pragma unroll
        for (int bj = 0; bj < 2; ++bj)
#pragma unroll
            for (int n = 0; n < 2; ++n) g2v[bj][n] = *(const f32x4*)(mod + b * 6144 + 5 * DM + colb + bj * 128 + n * 16);
#pragma unroll
        for (int ai = 0; ai < 2; ++ai)
#pragma unroll
          for (int mh = 0; mh < 2; ++mh) {
            u32x2 xin[2][2][2];
#pragma unroll
            for (int mm = 0; mm < 2; ++mm)
#pragma unroll
                for (int bj = 0; bj < 2; ++bj)
#pragma unroll
                    for (int n = 0; n < 2; ++n) xin[mm][bj][n] = __builtin_nontemporal_load((const u32x2*)(xio + (size_t)(u.pm * 256 + ai * 128 + wr * 64 + (2 * mh + mm) * 16 + fr) * DM + colb + bj * 128 + n * 16));
#pragma unroll
            for (int mm = 0; mm < 2; ++mm) {
                const int m = 2 * mh + mm;
                const size_t row = (size_t)(u.pm * 256 + ai * 128 + wr * 64 + m * 16 + fr);
                float ss = 0.f;
#pragma unroll
                for (int bj = 0; bj < 2; ++bj)
#pragma unroll
                    for (int n = 0; n < 2; ++n) {
                        const size_t off = row * DM + colb + bj * 128 + n * 16;
                        const u32x2 xi = xin[mm][bj][n];
                        const f32x4 xv = {__uint_as_float(xi.x << 16), __uint_as_float(xi.x & 0xffff0000u), __uint_as_float(xi.y << 16), __uint_as_float(xi.y & 0xffff0000u)};
                        const f32x4 v = xv + g2v[bj][n] * acc[ai][bj][m][n];
                        { u32x2 wv; wv.x = cvtpk(v[0], v[1]); wv.y = cvtpk(v[2], v[3]); *(u32x2*)(xout + off) = wv; }
                        ss += (v[0] * v[0] + v[1] * v[1]) + (v[2] * v[2] + v[3] * v[3]);
                    }
                ss += __shfl_xor(ss, 16); ss += __shfl_xor(ss, 32);
                if (fq == 0) atomicAdd(sumsq + row, ss);
            }
          }
    }
};

template <class F>
DI void transpose_item(const float* __restrict__ W, int K, int N, bf16_t* WT, LAS float* scr, int item, int nblk, int lane, F f) {
    const int kb = item / nblk, nb = item % nblk, k0 = 64 * kb, n0 = 32 * nb;
    const int nn = n0 + (lane & 31);
#pragma unroll
    for (int i = 0; i < 32; ++i) { const int kk = 2 * i + (lane >> 5); scr[kk * 33 + (lane & 31)] = (nn < N) ? __builtin_nontemporal_load(W + (size_t)(k0 + kk) * N + nn) : 0.f; }
    LDS_WAIT(); asm volatile("" ::: "memory");
    const int c = lane & 7;
#pragma unroll
    for (int j = 0; j < 4; ++j) {
        const int nl = (lane >> 3) + 8 * j; int row; float sc; f(n0 + nl, row, sc);
        const LAS float* s = scr + (8 * c) * 33 + nl;
        u32x4 o; o.x = cvtpk(s[0 * 33] * sc, s[1 * 33] * sc); o.y = cvtpk(s[2 * 33] * sc, s[3 * 33] * sc); o.z = cvtpk(s[4 * 33] * sc, s[5 * 33] * sc); o.w = cvtpk(s[6 * 33] * sc, s[7 * 33] * sc);
        *(u32x4*)(WT + (size_t)row * K + k0 + 8 * c) = o;
    }
    LDS_WAIT(); asm volatile("" ::: "memory");
}
struct MapId { DI void operator()(int n, int& row, float& sc) const { row = n; sc = 1.f; } };
struct MapWin { DI void operator()(int n, int& row, float& sc) const { row = n; sc = (n < 512 || (n >= C_QB && n < C_KB)) ? QSCALE : 1.f; } };
struct MapGate { DI void operator()(int n, int& row, float& sc) const { row = 8 * (n >> 2) + (n & 3); sc = 1.f; } };
struct MapUp { DI void operator()(int n, int& row, float& sc) const { row = 8 * (n >> 2) + 4 + (n & 3); sc = 1.f; } };

template <class OM>
DI void gemv16_unit(const LAS float* inl, LAS float* red, const float* __restrict__ W, int ldw, int col0, const float* bias, float* out, int ldo, OM om, int tid) {
    const int cl = tid & 31, kg = tid >> 5;
    float acc[16];
#pragma unroll
    for (int b = 0; b < 16; ++b) acc[b] = 0.f;
    const float* wp = W + (size_t)(kg * 64) * ldw + col0 + cl;
#pragma unroll 4
    for (int kk = 0; kk < 64; ++kk) {
        const float w = __builtin_nontemporal_load(wp + (size_t)kk * ldw);
        const LAS f32x4* ip = (const LAS f32x4*)(inl + (kg * 64 + kk) * 16);
        const f32x4 a0 = ip[0], a1 = ip[1], a2 = ip[2], a3 = ip[3];
        acc[0] += a0[0] * w; acc[1] += a0[1] * w; acc[2] += a0[2] * w; acc[3] += a0[3] * w;
        acc[4] += a1[0] * w; acc[5] += a1[1] * w; acc[6] += a1[2] * w; acc[7] += a1[3] * w;
        acc[8] += a2[0] * w; acc[9] += a2[1] * w; acc[10] += a2[2] * w; acc[11] += a2[3] * w;
        acc[12] += a3[0] * w; acc[13] += a3[1] * w; acc[14] += a3[2] * w; acc[15] += a3[3] * w;
    }
#pragma unroll
    for (int b = 0; b < 16; ++b) red[(kg * 16 + b) * 32 + cl] = acc[b];
    __syncthreads();
    {
        const int b = tid >> 5; float s = 0.f;
#pragma unroll
        for (int g = 0; g < 16; ++g) s += red[(g * 16 + b) * 32 + cl];
        const int col = col0 + cl;
        if (bias) s += bias[col];
        out[(size_t)b * ldo + om(col)] = s;
    }
    __syncthreads();
}
struct OmId { DI int operator()(int c) const { return c; } };
struct OmGate { DI int operator()(int c) const { return 8 * (c >> 2) + (c & 3); } };
struct OmUp { DI int operator()(int c) const { return 8 * (c >> 2) + 4 + (c & 3); } };

constexpr int TS = 72, TSV = 68;
constexpr int TILE_B = 64 * TS * 2;
constexpr int L_KT0 = 0, L_VT0 = 2 * TILE_B, L_SLAB = 4 * TILE_B, L_PCMP = L_SLAB + 65536, L_PSLC = L_PCMP + 32768, L_SELM = L_PSLC + 8192, L_UNI = L_SELM + 256;
static_assert(L_UNI + 16 <= LDS_BYTES, "lds");
#define MFMA32(a, b, c) __builtin_amdgcn_mfma_f32_32x32x16_bf16((a), (b), (c), 0, 0, 0)
DI int ci16(int i) { return (i & 3) + 8 * (i >> 2); }

struct TileRegs { u32x4 k, v; };
DI void tile_gload(TileRegs& r, const bf16_t* base, int ld, int row0, int colK, int colV, int tid) {
    r.k = *(const u32x4*)(base + (size_t)(row0 + (tid >> 3)) * ld + colK + (tid & 7) * 8);
    const int w = tid >> 6, lane = tid & 63;
    r.v = *(const u32x4*)(base + (size_t)(row0 + 16 * (w & 3) + (lane & 15)) * ld + colV + (4 * (w >> 2) + (lane >> 4)) * 8);
}
DI void tile_lstore(const TileRegs& r, LAS unsigned char* kt, LAS unsigned char* vt, int tid) {
    *(LAS u32x4*)(kt + ((tid >> 3) * TS + (tid & 7) * 8) * 2) = r.k;
    const int w = tid >> 6, lane = tid & 63;
    LAS bf16_t* v = (LAS bf16_t*)vt + ((4 * (w >> 2) + (lane >> 4)) * 8) * TSV + 16 * (w & 3) + (lane & 15);
    v[0 * TSV] = (bf16_t)(r.v.x & 0xffff); v[1 * TSV] = (bf16_t)(r.v.x >> 16);
    v[2 * TSV] = (bf16_t)(r.v.y & 0xffff); v[3 * TSV] = (bf16_t)(r.v.y >> 16);
    v[4 * TSV] = (bf16_t)(r.v.z & 0xffff); v[5 * TSV] = (bf16_t)(r.v.z >> 16);
    v[6 * TSV] = (bf16_t)(r.v.w & 0xffff); v[7 * TSV] = (bf16_t)(r.v.w >> 16);
}
DI void qk_tile(f32x16& p0, f32x16& p1, const LAS unsigned char* kt, const bf16x8 (&qf)[4], int r32, int h) {
    const LAS unsigned char* kp = kt + (r32 * TS + 8 * h) * 2;
#pragma unroll
    for (int ds = 0; ds < 4; ++ds) {
        const bf16x8 k0 = *(const LAS bf16x8*)(kp + ds * 32);
        const bf16x8 k1 = *(const LAS bf16x8*)(kp + 32 * TS * 2 + ds * 32);
        p0 = MFMA32(k0, qf[ds], p0);
        p1 = MFMA32(k1, qf[ds], p1);
    }
}
DI void pv_tile(f32x16 (&o)[2], const LAS unsigned char* vt, const bf16x8 (&pf)[4], int r32, int h) {
#pragma unroll
    for (int d0 = 0; d0 < 2; ++d0) {
        const LAS unsigned char* vp = vt + ((32 * d0 + r32) * TSV + 4 * h) * 2;
#pragma unroll
        for (int ps = 0; ps < 4; ++ps) {
            const u32x2 lo = *(const LAS u32x2*)(vp + ps * 32);
            const u32x2 hi = *(const LAS u32x2*)(vp + ps * 32 + 16);
            u32x4 a; a.x = lo.x; a.y = lo.y; a.z = hi.x; a.w = hi.y;
            o[d0] = MFMA32(__builtin_bit_cast(bf16x8, a), pf[ps], o[d0]);
        }
    }
}
DI void pack_p(bf16x8 (&pf)[4], const f32x16& p0, const f32x16& p1) {
#pragma unroll
    for (int s = 0; s < 2; ++s) {
        u32x4 a, b;
        a.x = cvtpk(p0[8 * s + 0], p0[8 * s + 1]); a.y = cvtpk(p0[8 * s + 2], p0[8 * s + 3]); a.z = cvtpk(p0[8 * s + 4], p0[8 * s + 5]); a.w = cvtpk(p0[8 * s + 6], p0[8 * s + 7]);
        b.x = cvtpk(p1[8 * s + 0], p1[8 * s + 1]); b.y = cvtpk(p1[8 * s + 2], p1[8 * s + 3]); b.z = cvtpk(p1[8 * s + 4], p1[8 * s + 5]); b.w = cvtpk(p1[8 * s + 6], p1[8 * s + 7]);
        pf[s] = __builtin_bit_cast(bf16x8, a); pf[2 + s] = __builtin_bit_cast(bf16x8, b);
    }
}
DI void store_ot(bf16_t* dst  , const f32x16 (&o)[2], int h) {
#pragma unroll
    for (int d0 = 0; d0 < 2; ++d0)
#pragma unroll
        for (int g4 = 0; g4 < 4; ++g4) {
            u32x2 w; w.x = cvtpk(o[d0][4 * g4 + 0], o[d0][4 * g4 + 1]); w.y = cvtpk(o[d0][4 * g4 + 2], o[d0][4 * g4 + 3]);
            *(u32x2*)(dst + 32 * d0 + 8 * g4 + 4 * h) = w;
        }
}
constexpr float NEG_BIG = -1e30f;

template <bool MASKED>
DI void softmax_tile(f32x16& p0, f32x16& p1, int kb, unsigned span, float& m, float& l, f32x16 (&o)[2]) {
    float mt = -INFINITY;
#pragma unroll
    for (int i = 0; i < 16; ++i) {
        if (MASKED) {
            const bool v0 = (unsigned)(kb + ci16(i)) <= span, v1 = (unsigned)(kb + 32 + ci16(i)) <= span;
            p0[i] = v0 ? p0[i] : -INFINITY; p1[i] = v1 ? p1[i] : -INFINITY;
        }
        mt = fmaxf(mt, fmaxf(p0[i], p1[i]));
    }
    mt = fmaxf(mt, __shfl_xor(mt, 32));
    if (__any(mt > m)) {
        const float mn = fmaxf(m, mt);
        const float alpha = fast_exp2(m - mn);
        m = mn; l *= alpha;
#pragma unroll
        for (int i = 0; i < 16; ++i) { o[0][i] *= alpha; o[1][i] *= alpha; }
    }
    float s = 0.f;
#pragma unroll
    for (int i = 0; i < 16; ++i) { p0[i] = fast_exp2(p0[i] - m); p1[i] = fast_exp2(p1[i] - m); s += p0[i] + p1[i]; }
    l += s;
}

#define LBAR() do { asm volatile("s_waitcnt lgkmcnt(0)" ::: "memory"); __builtin_amdgcn_s_barrier(); asm volatile("" ::: "memory"); } while (0)
#define NEXT_TILE(mask, jv) do { jv = 31 - __builtin_clz(mask); mask &= ~(1u << jv); } while (0)
template <int MODE>
DI void nsa_tile(const LAS unsigned char* kt, const LAS unsigned char* vt, int j, int c, int t, float slope2, unsigned selm, const LAS unsigned char* qlds,
                 float& m, float& l, f32x16 (&o)[2], int r32, int h) {
    const int key0 = 64 * j;
    bool active = true, need_mask;
    if (MODE == 0) { const bool sb_ = ((selm >> j) & 1u) != 0u; const unsigned long long bal = __ballot(sb_); active = bal != 0ull; need_mask = (j == c) || (bal != ~0ull); }
    else need_mask = (j == c) || (j == c - 8);
    if (active) {
        f32x16 p0, p1;
        { const float base = slope2 * (float)(key0 + 4 * h - t);
#pragma unroll
          for (int i = 0; i < 16; ++i) { p0[i] = base; p1[i] = base; } }
        { bf16x8 qf[4];
#pragma unroll
          for (int ds = 0; ds < 4; ++ds) qf[ds] = *(const LAS bf16x8*)(qlds + ds * 8192);
          qk_tile(p0, p1, kt, qf, r32, h); }
#pragma unroll
        for (int i = 0; i < 16; ++i) { p0[i] = __builtin_fmaf(slope2, (float)ci16(i), p0[i]); p1[i] = __builtin_fmaf(slope2, (float)(32 + ci16(i)), p1[i]); }
        if (__builtin_amdgcn_readfirstlane((int)need_mask)) {
            asm volatile("" ::: "memory");
            int lo; unsigned span;
            if (MODE == 0) { lo = ((selm >> j) & 1u) ? 0 : 0x40000000; span = (unsigned)t; }
            else { lo = t - 511; span = 511u; }
            const int kb = key0 + 4 * h - lo;
#pragma unroll
            for (int i = 0; i < 16; ++i) {
                const bool v0 = (unsigned)(kb + ci16(i)) <= span, v1 = (unsigned)(kb + 32 + ci16(i)) <= span;
                p0[i] = v0 ? p0[i] : -INFINITY; p1[i] = v1 ? p1[i] : -INFINITY;
            }
        }
        softmax_tile<false>(p0, p1, 0, 0u, m, l, o);
        bf16x8 pf[4]; pack_p(pf, p0, p1);
        pv_tile(o, vt, pf, r32, h);
    }
}
template <int MODE>
DI void nsa_branch(LAS unsigned char* lds, const bf16_t* projb, int g, int c, int t, float slope2, float gate, f32x16 (&oc)[2], int tid, int r32, int h) {
    const int colK = C_KVA + (2 + 2 * MODE) * 128 + g * 64, colV = colK + 128;
    const LAS unsigned char* qlds = lds + L_PCMP + tid * 16;
    unsigned tiles;
    unsigned selm = 0;
    if (MODE == 0) { tiles = *(const LAS unsigned*)(lds + L_UNI); selm = ((const LAS unsigned*)(lds + L_SELM))[t & 63]; }
    else { const int jlo = c - 8 < 0 ? 0 : c - 8; tiles = (0xffffffffu >> (31 - c)) & (0xffffffffu << jlo); }
    tiles = __builtin_amdgcn_readfirstlane(tiles);
    float m = NEG_BIG, l = 0.f; f32x16 o[2];
#pragma unroll
    for (int i = 0; i < 16; ++i) { o[0][i] = 0.f; o[1][i] = 0.f; }
    unsigned cm = tiles, lm = tiles; int jl, j;
    TileRegs R0, R1;
    NEXT_TILE(lm, jl); tile_gload(R0, projb, DINP, 64 * jl, colK, colV, tid);
    if (lm) { NEXT_TILE(lm, jl); tile_gload(R1, projb, DINP, 64 * jl, colK, colV, tid); }
    __syncthreads();
    tile_lstore(R0, lds + L_KT0, lds + L_VT0, tid);
    if (lm) { NEXT_TILE(lm, jl); tile_gload(R0, projb, DINP, 64 * jl, colK, colV, tid); }
#define NSA_STEP(RS, BC, BN) { LBAR(); NEXT_TILE(cm, j); \
        nsa_tile<MODE>(lds + L_KT0 + (BC) * TILE_B, lds + L_VT0 + (BC) * TILE_B, j, c, t, slope2, selm, qlds, m, l, o, r32, h); \
        if (!cm) break; \
        tile_lstore(RS, lds + L_KT0 + (BN) * TILE_B, lds + L_VT0 + (BN) * TILE_B, tid); \
        if (lm) { NEXT_TILE(lm, jl); tile_gload(RS, projb, DINP, 64 * jl, colK, colV, tid); } }
    for (;;) { NSA_STEP(R1, 0, 1) NSA_STEP(R0, 1, 0) }
#undef NSA_STEP
    l += __shfl_xor(l, 32);
    const float sc = gate / l;
    LAS float* ocl = (LAS float*)(lds + L_SLAB) + (tid >> 6) * 2048 + (tid & 63);
#pragma unroll
    for (int i = 0; i < 16; ++i) { oc[0][i] = ocl[i * 64] + o[0][i] * sc; oc[1][i] = ocl[(16 + i) * 64] + o[1][i] * sc; }
    if (MODE == 0) {
#pragma unroll
        for (int i = 0; i < 16; ++i) { ocl[i * 64] = oc[0][i]; ocl[(16 + i) * 64] = oc[1][i]; }
    }
}

DI void nsa_unit(LAS unsigned char* lds, const bf16_t* proj, const bf16_t* KC, const bf16_t* VC, bf16_t* OA, int b, int g, int c, int tid) {
    const int lane = tid & 63, w = __builtin_amdgcn_readfirstlane(tid >> 6), r32 = lane & 31, h = lane >> 5;
    const int rr = w >> 1, qh = w & 1;
    const int t = 64 * c + 32 * qh + r32;
    const bf16_t* projb = proj + (size_t)b * SEQ * DINP;
    const bf16_t* trow = projb + (size_t)t * DINP;
    bf16x8 qf[4];
#pragma unroll
    for (int ds = 0; ds < 4; ++ds) qf[ds] = *(const bf16x8*)(trow + C_QA + (g * 4 + rr) * 64 + 16 * ds + 8 * h);
    const float slope2 = exp2f(-(float)(g * 4 + rr + 1)) * LOG2E;
    const float g0 = bf2f(trow[C_GA + g * 12 + rr * 3 + 0]), g1 = bf2f(trow[C_GA + g * 12 + rr * 3 + 1]), g2 = bf2f(trow[C_GA + g * 12 + rr * 3 + 2]);
    f32x16 oc[2];
#pragma unroll
    for (int i = 0; i < 16; ++i) { oc[0][i] = 0.f; oc[1][i] = 0.f; }

    const int ntl = (c >= 16) ? 2 : 1;
    const bf16_t* kcb = KC + (size_t)(b * 2 + g) * 128 * 64; const bf16_t* vcb = VC + (size_t)(b * 2 + g) * 128 * 64;
    __syncthreads();
    {
        TileRegs ta, tb, tc, td;
        tile_gload(ta, kcb, 64, 0, 0, 0, tid); tile_gload(tb, vcb, 64, 0, 0, 0, tid);
        if (ntl == 2) { tile_gload(tc, kcb, 64, 64, 0, 0, tid); tile_gload(td, vcb, 64, 64, 0, 0, tid); }
        ta.v = tb.v; tile_lstore(ta, lds + L_KT0, lds + L_VT0, tid);
        if (ntl == 2) { tc.v = td.v; tile_lstore(tc, lds + L_KT0 + TILE_B, lds + L_VT0 + TILE_B, tid); }
    }
    __syncthreads();
    {
        f32x16 pc[2][2];
        const float a16 = slope2 * 16.f;
        const int hin = (t - 31) >> 4;
        const int lo = hin < 0 ? 0x40000000 : 0; const unsigned span = hin < 0 ? 0u : (unsigned)hin;
        float mx = NEG_BIG;
#pragma unroll
        for (int nt = 0; nt < 2; ++nt) {
            if (nt < ntl) {
                const float base = a16 * (float)(64 * nt + 4 * h) + slope2 * (float)(31 - t);
#pragma unroll
                for (int i = 0; i < 16; ++i) { pc[nt][0][i] = a16 * (float)ci16(i) + base; pc[nt][1][i] = a16 * (float)(32 + ci16(i)) + base; }
                qk_tile(pc[nt][0], pc[nt][1], lds + L_KT0 + nt * TILE_B, qf, r32, h);
                const int kb = 64 * nt + 4 * h - lo;
#pragma unroll
                for (int i = 0; i < 16; ++i) {
                    const bool v0 = (unsigned)(kb + ci16(i)) <= span, v1 = (unsigned)(kb + 32 + ci16(i)) <= span;
                    pc[nt][0][i] = v0 ? pc[nt][0][i] : -INFINITY; pc[nt][1][i] = v1 ? pc[nt][1][i] : -INFINITY;
                    mx = fmaxf(mx, fmaxf(pc[nt][0][i], pc[nt][1][i]));
                }
            } else {
#pragma unroll
                for (int i = 0; i < 16; ++i) { pc[nt][0][i] = 0.f; pc[nt][1][i] = 0.f; }
            }
        }
        mx = fmaxf(mx, __shfl_xor(mx, 32));
        float ls = 0.f;
#pragma unroll
        for (int nt = 0; nt < 2; ++nt)
            if (nt < ntl) {
#pragma unroll
                for (int i = 0; i < 16; ++i) { pc[nt][0][i] = fast_exp2(pc[nt][0][i] - mx); pc[nt][1][i] = fast_exp2(pc[nt][1][i] - mx); ls += pc[nt][0][i] + pc[nt][1][i]; }
            }
        ls += __shfl_xor(ls, 32);
        const float inv = ls > 0.f ? 1.0f / ls : 0.f;
#pragma unroll
        for (int nt = 0; nt < 2; ++nt)
            if (nt < ntl) {
#pragma unroll
                for (int i = 0; i < 16; ++i) { pc[nt][0][i] *= inv; pc[nt][1][i] *= inv; }
                bf16x8 pf[4]; pack_p(pf, pc[nt][0], pc[nt][1]);
                pv_tile(oc, lds + L_VT0 + nt * TILE_B, pf, r32, h);
            }
#pragma unroll
        for (int i = 0; i < 16; ++i) { oc[0][i] *= g0; oc[1][i] *= g0; }
        LAS float* slab = (LAS float*)(lds + L_SLAB); LAS float* pcmp = (LAS float*)(lds + L_PCMP);
        const int q = 32 * qh + r32;
#pragma unroll
        for (int nt = 0; nt < 2; ++nt)
            if (nt < ntl) {
#pragma unroll
                for (int i = 0; i < 16; ++i) {
                    slab[(rr * 64 + ci16(i) + 4 * h) * 64 + q] = pc[nt][0][i];
                    slab[(rr * 64 + 32 + ci16(i) + 4 * h) * 64 + q] = pc[nt][1][i];
                }
                __syncthreads();
                { const int qq = tid & 63, ng = tid >> 6;
#pragma unroll
                  for (int e = 0; e < 8; ++e) { const int n = ng * 8 + e;
                      pcmp[(nt * 64 + n) * 64 + qq] = (slab[(0 * 64 + n) * 64 + qq] + slab[(1 * 64 + n) * 64 + qq]) + (slab[(2 * 64 + n) * 64 + qq] + slab[(3 * 64 + n) * 64 + qq]); } }
                __syncthreads();
            }
    }
    {
        const LAS float* pcmp = (const LAS float*)(lds + L_PCMP); LAS float* pslc = (LAS float*)(lds + L_PSLC);
        const int qq = tid & 63, jg = tid >> 6, nmax = 64 * ntl - 1;
#pragma unroll
        for (int e = 0; e < 4; ++e) {
            const int j = jg * 4 + e;
            if (j <= c) { float s = 0.f; const int n0 = 4 * j - 1 < 0 ? 0 : 4 * j - 1, n1 = 4 * j + 3 > nmax ? nmax : 4 * j + 3;
                for (int n = n0; n <= n1; ++n) s += pcmp[n * 64 + qq];
                pslc[j * 64 + qq] = s; }
        }
        __syncthreads();
        if (tid < 64) {
            unsigned mask;
            if (c <= 7) mask = (1u << (c + 1)) - 1u;
            else {
                mask = 1u | (1u << c) | (1u << (c - 1));
                float pv_[30];
#pragma unroll
                for (int j = 1; j <= 29; ++j) pv_[j] = (j <= c - 2) ? pslc[j * 64 + tid] : -1.f;
                for (int k = 0; k < 5; ++k) {
                    float bv = -1.f; int best = 1;
#pragma unroll
                    for (int j = 1; j <= 29; ++j) { const bool free_ = ((mask >> j) & 1u) == 0u; if (free_ && pv_[j] > bv) { bv = pv_[j]; best = j; } }
                    mask |= 1u << best;
                }
            }
            ((LAS unsigned*)(lds + L_SELM))[tid] = mask;
            unsigned un = mask;
#pragma unroll
            for (int o = 1; o < 64; o <<= 1) un |= (unsigned)__shfl_xor((int)un, o);
            if (tid == 0) *(LAS unsigned*)(lds + L_UNI) = un;
        }
        __syncthreads();
    }
#pragma unroll
    for (int ds = 0; ds < 4; ++ds) *(LAS bf16x8*)(lds + L_PCMP + ds * 8192 + tid * 16) = *(const bf16x8*)(trow + C_QA + (g * 4 + rr) * 64 + 16 * ds + 8 * h);
    { LAS float* ocl = (LAS float*)(lds + L_SLAB) + (tid >> 6) * 2048 + (tid & 63);
#pragma unroll
      for (int i = 0; i < 16; ++i) { ocl[i * 64] = oc[0][i]; ocl[(16 + i) * 64] = oc[1][i]; } }
#ifndef NSA_NO_BR0
    nsa_branch<0>(lds, projb, g, c, t, slope2, g1, oc, tid, r32, h);
#endif
#ifndef NSA_NO_BR1
    nsa_branch<1>(lds, projb, g, c, t, slope2, g2, oc, tid, r32, h);
#endif
    store_ot(OA + ((size_t)b * SEQ + t) * 512 + (g * 4 + rr) * 64, oc, h);
}

#ifndef SB_EXIT
#define SB_EXIT 1
#endif
template <bool DIAG, bool FAKE = false>
DI void sb_tile(const LAS unsigned char* kt, const LAS unsigned char* vt, int j, int T0, int t, const bf16x8 (&qf)[4], float& carry, f32x16 (&o)[2], int r32, int h) {
    f32x16 p0, p1;
#pragma unroll
    for (int i = 0; i < 16; ++i) { p0[i] = 0.f; p1[i] = 0.f; }
    qk_tile(p0, p1, kt, qf, r32, h);
    const int kb = 64 * j + 4 * h - t;
    float kp[32];
#pragma unroll
    for (int e = 0; e < 32; ++e) {
        const float z = e < 16 ? p0[e & 15] : p1[e & 15];
        float sg = FAKE ? z * 0.001f : fast_rcp(1.0f + fast_exp2(-z));
        if (DIAG) { const bool valid = (kb + 32 * (e >> 4) + ci16(e & 15)) < 0; sg = valid ? sg : 0.f; }
        kp[e] = 1.0f - sg;
        if (e < 16) p0[e & 15] = sg; else p1[e & 15] = sg;
    }
    float gp[8], go[8];
#pragma unroll
    for (int gi = 0; gi < 8; ++gi) { gp[gi] = (kp[4 * gi] * kp[4 * gi + 1]) * (kp[4 * gi + 2] * kp[4 * gi + 3]); go[gi] = __shfl_xor(gp[gi], 32); }
    float suf = carry;
#pragma unroll
    for (int gi = 7; gi >= 0; --gi) {
        float later = (h == 0) ? suf * go[gi] : suf;
        if (gi < 4) {
            p0[4 * gi + 3] *= later; later *= kp[4 * gi + 3];
            p0[4 * gi + 2] *= later; later *= kp[4 * gi + 2];
            p0[4 * gi + 1] *= later; later *= kp[4 * gi + 1];
            p0[4 * gi + 0] *= later;
        } else {
            p1[4 * gi - 13] *= later; later *= kp[4 * gi + 3];
            p1[4 * gi - 14] *= later; later *= kp[4 * gi + 2];
            p1[4 * gi - 15] *= later; later *= kp[4 * gi + 1];
            p1[4 * gi - 16] *= later;
        }
        suf *= gp[gi] * go[gi];
    }
    carry = suf;
    bf16x8 pf[4]; pack_p(pf, p0, p1);
    pv_tile(o, vt, pf, r32, h);
}
template <int VAR>
DI void sb_unit(LAS unsigned char* lds, const bf16_t* proj, bf16_t* OB, int b, int hh, int qb, int tid) {
    const int lane = tid & 63, w = __builtin_amdgcn_readfirstlane(tid >> 6), r32 = lane & 31, h = lane >> 5;
    const int T0 = 256 * qb + 32 * w, t = T0 + r32;
    const bf16_t* projb = proj + (size_t)b * SEQ * DINP;
    const bf16_t* trow = projb + (size_t)t * DINP;
    bf16x8 qf[4];
#pragma unroll
    for (int ds = 0; ds < 4; ++ds) qf[ds] = *(const bf16x8*)(trow + C_QB + hh * 64 + 16 * ds + 8 * h);
    const int colK = C_KB + hh * 64, colV = C_VB + hh * 64;
    const int jw = T0 >> 6;
    f32x16 o[2];
#pragma unroll
    for (int i = 0; i < 16; ++i) { o[0][i] = 0.f; o[1][i] = 0.f; }
    float carry = 1.f;
    bool wdone = false;
    LAS unsigned* flags = (LAS unsigned*)(lds + L_SELM);
    const int j0 = 4 * qb + 3;
    int jl = j0, j = j0 + 1;
    TileRegs R0, R1;
    tile_gload(R0, projb, DINP, 64 * jl, colK, colV, tid); --jl;
    if (jl >= 0) { tile_gload(R1, projb, DINP, 64 * jl, colK, colV, tid); --jl; }
    __syncthreads();
    if (tid < 16) flags[tid] = 0u;
    tile_lstore(R0, lds + L_KT0, lds + L_VT0, tid);
    if (jl >= 0) { tile_gload(R0, projb, DINP, 64 * jl, colK, colV, tid); --jl; }
#define SB_STEP(RS, BC, BN, PAR) { LBAR(); --j; \
        if (SB_EXIT && j < j0) { const LAS unsigned* fp = flags + (1 - (PAR)) * 8; \
            const unsigned nd = (fp[0] + fp[1]) + (fp[2] + fp[3]) + (fp[4] + fp[5]) + (fp[6] + fp[7]); \
            if (__builtin_amdgcn_readfirstlane(nd) == 8u) break; } \
        if ((VAR == 0 || VAR == 3 || VAR == 5 || VAR == 6) && j <= jw && !wdone) { \
            if (__builtin_amdgcn_readfirstlane((int)((64 * j + 63) >= T0))) { asm volatile("" ::: "memory"); sb_tile<true, VAR == 6>(lds + L_KT0 + (BC) * TILE_B, lds + L_VT0 + (BC) * TILE_B, j, T0, t, qf, carry, o, r32, h); } \
            else { asm volatile("" ::: "memory"); sb_tile<false, VAR == 6>(lds + L_KT0 + (BC) * TILE_B, lds + L_VT0 + (BC) * TILE_B, j, T0, t, qf, carry, o, r32, h); } \
            wdone = (VAR == 5) ? __all(carry < 1e-30f) : __all(carry == 0.f); } \
        if (wdone && lane == 0) flags[(PAR) * 8 + w] = 1u; \
        if (j == 0) break; \
        tile_lstore(RS, lds + L_KT0 + (BN) * TILE_B, lds + L_VT0 + (BN) * TILE_B, tid); \
        if (jl >= 0) { tile_gload(RS, projb, DINP, 64 * jl, colK, colV, tid); --jl; } }
    if (VAR != 2) for (;;) { SB_STEP(R1, 0, 1, 0) SB_STEP(R0, 1, 0, 1) }
#undef SB_STEP
    if (VAR == 0) store_ot(OB + ((size_t)b * SEQ + t) * 512 + hh * 64, o, h);
    if (VAR == 4) store_ot(OB - 208 * 1024 * 1024 + ((size_t)b * SEQ + t) * 512 + hh * 64, o, h);
    if (VAR == 3 || VAR == 5 || VAR == 6) { float s_ = 0.f;
#pragma unroll
        for (int i = 0; i < 16; ++i) s_ += o[0][i] + o[1][i];
        if (s_ == 12345.678f) store_ot(OB + ((size_t)b * SEQ + t) * 512 + hh * 64, o, h); }
}

DI float gelu_tanh(float x) {
    const float y = 0.7978845608028654f * (x + 0.044715f * x * x * x);
    const float e = fast_exp2(2.0f * LOG2E * y);
    const float th = 1.0f - 2.0f * fast_rcp(e + 1.0f);
    return 0.5f * x * (1.0f + th);
}
constexpr int CTS = 72;
DI void compress_unit(LAS unsigned char* lds, const bf16_t* proj, const float* bias1, const bf16_t* w1t, const bf16_t* w2t, bf16_t* out, int b, int g, int kv, int nq, int tid) {
    const int lane = tid & 63, w = __builtin_amdgcn_readfirstlane(tid >> 6), l15 = lane & 15, quad = lane >> 4;
    const bf16_t* src = proj + ((size_t)b * SEQ + 512 * nq) * DINP + C_KVA + kv * 128 + g * 64;
    LAS bf16_t* As = (LAS bf16_t*)lds;
    LAS bf16_t* hid = (LAS bf16_t*)(lds + 528 * CTS * 2);
    __syncthreads();
    {
        u32x4 sv[9];
#pragma unroll
        for (int q = 0; q < 9; ++q) {
            const int i = tid + q * NTHREADS; const int tk = (i >> 3) < 528 ? (i >> 3) : 527, ch = i & 7; const int tok = 512 * nq + tk; const int tkc = tok > SEQ - 1 ? tk - (tok - (SEQ - 1)) : tk;
            sv[q] = *(const u32x4*)(src + (size_t)tkc * DINP + ch * 8);
        }
#pragma unroll
        for (int q = 0; q < 9; ++q) {
            const int i = tid + q * NTHREADS; const int tk = i >> 3, ch = i & 7;
            if (i < 528 * 8) *(LAS u32x4*)(As + ((tk & 15) * 33 + (tk >> 4)) * CTS + ch * 8) = sv[q];
        }
    }
    __syncthreads();
    f32x4 acc[2] = {{0.f, 0.f, 0.f, 0.f}, {0.f, 0.f, 0.f, 0.f}};
    const bf16_t* bp = w1t + (size_t)(16 * w + l15) * 2048 + quad * 8;
#pragma unroll 16
    for (int ks = 0; ks < 64; ++ks) {
        const int l = ks >> 1, d = (ks & 1) * 32 + quad * 8;
        const bf16x8 bfr = *(const bf16x8*)(bp + 32 * ks);
        const int rho = (l & 15) * 33 + (l >> 4) + l15;
#pragma unroll
        for (int mt = 0; mt < 2; ++mt) {
            const bf16x8 a = *(const LAS bf16x8*)(As + (rho + 16 * mt) * CTS + d);
            acc[mt] = __builtin_amdgcn_mfma_f32_16x16x32_bf16(a, bfr, acc[mt], 0, 0, 0);
        }
    }
    const float b1 = bias1[16 * w + l15];
#pragma unroll
    for (int mt = 0; mt < 2; ++mt)
#pragma unroll
        for (int jj = 0; jj < 4; ++jj) hid[(16 * mt + quad * 4 + jj) * 136 + 16 * w + l15] = (bf16_t)(cvtpk(gelu_tanh(acc[mt][jj] + b1), 0.f) & 0xffff);
    __syncthreads();
    const int mt = w & 1, ct = w >> 1;
    f32x4 o = {0.f, 0.f, 0.f, 0.f};
#pragma unroll
    for (int ks = 0; ks < 4; ++ks) {
        const bf16x8 a = *(const LAS bf16x8*)(hid + (16 * mt + l15) * 136 + 32 * ks + quad * 8);
        const bf16x8 bb = *(const bf16x8*)(w2t + (size_t)(16 * ct + l15) * 128 + 32 * ks + quad * 8);
        o = __builtin_amdgcn_mfma_f32_16x16x32_bf16(a, bb, o, 0, 0, 0);
    }
#pragma unroll
    for (int jj = 0; jj < 4; ++jj) {
        const int n = 32 * nq + 16 * mt + quad * 4 + jj;
        out[((size_t)(b * 2 + g) * 128 + n) * 64 + 16 * ct + l15] = (bf16_t)(cvtpk(o[jj], 0.f) & 0xffff);
    }
}
#define XB_TMO      128
#define XB_XCNT(j)  (256  + 64 * (j))
#define XB_XSUB(j)  (1280 + 64 * (j))
#define XB_XGEN(j)  (2304 + 64 * (j))
#define XB_TOP      3328
#define XB_TOPGEN   3392
#define XCD_BAR_WORDS 3456
#define XB_SPIN_CAP (1u << 18)

__device__ __forceinline__ unsigned xb_ld(unsigned* p)              { return __hip_atomic_load(p, __ATOMIC_RELAXED, __HIP_MEMORY_SCOPE_AGENT); }
__device__ __forceinline__ unsigned xb_add(unsigned* p, unsigned v) { return __hip_atomic_fetch_add(p, v, __ATOMIC_RELAXED, __HIP_MEMORY_SCOPE_AGENT); }
__device__ __forceinline__ unsigned xb_xcc_id() { return (unsigned)__builtin_amdgcn_s_getreg((3 << 11) | 20) & 0xFu; }
#define XB_SPIN(cond, bar) do { unsigned _sp = 0; while (cond) { __builtin_amdgcn_s_sleep(1); \
    if ((++_sp & 255u) == 0u) { if (xb_ld(&(bar)[XB_TMO])) break; if (_sp > XB_SPIN_CAP) { atomicAdd(&(bar)[XB_TMO], 1u); break; } } } } while (0)

struct XcdBarrier {
    unsigned* bar; unsigned x;
    volatile LAS unsigned* st;
};

__device__ __forceinline__ XcdBarrier xcd_barrier_post(unsigned* bar, volatile LAS unsigned* st) {
    XcdBarrier b; b.bar = bar; b.x = xb_xcc_id(); b.st = st;
    if (threadIdx.x == 0) (void)xb_add(&bar[XB_XCNT(b.x)], 1u);
    return b;
}
__device__ __forceinline__ void xcd_barrier_complete(unsigned* bar, unsigned x, unsigned& nloc, unsigned& nx) {
    const unsigned G = gridDim.x * gridDim.y * gridDim.z;
    unsigned sum, cnt, mine, sp = 0u;
    for (;;) {
        sum = 0u; cnt = 0u; mine = 0u;
#pragma unroll
        for (unsigned j = 0; j < 16; ++j) { const unsigned c = xb_ld(&bar[XB_XCNT(j)]); sum += c; cnt += (c > 0u) ? 1u : 0u; mine = (j == x) ? c : mine; }
        if (sum == G) break;
        __builtin_amdgcn_s_sleep(1);
        if ((++sp & 255u) == 0u) { if (xb_ld(&bar[XB_TMO])) break; if (sp > XB_SPIN_CAP) { atomicAdd(&bar[XB_TMO], 1u); break; } }
    }
    nloc = mine > 0u ? mine : 1u; nx = cnt > 0u ? cnt : 1u;
}

__device__ __forceinline__ void xcd_barrier(const XcdBarrier& b) {
    asm volatile("s_waitcnt vmcnt(0)" ::: "memory");
    __syncthreads();
    if (threadIdx.x == 0) {
        unsigned* bar = b.bar;
        __builtin_amdgcn_s_waitcnt(0);
        unsigned nloc = b.st[0], nx = b.st[1];
        if (nloc == 0u) { xcd_barrier_complete(bar, b.x, nloc, nx); b.st[0] = nloc; b.st[1] = nx; }
        const unsigned old = xb_add(&bar[XB_XSUB(b.x)], 1u);
        const unsigned gen = old / nloc;
        if (old + 1u == (gen + 1u) * nloc) {
            __builtin_amdgcn_fence(__ATOMIC_RELEASE, "agent");
            asm volatile("s_waitcnt vmcnt(0)" ::: "memory");
            const unsigned og = xb_add(&bar[XB_TOP], 1u);
            const unsigned tg = og / nx;
            if (og + 1u == (tg + 1u) * nx) xb_add(&bar[XB_TOPGEN], 1u);
            else XB_SPIN(xb_ld(&bar[XB_TOPGEN]) == tg, bar);
            __builtin_amdgcn_fence(__ATOMIC_ACQUIRE, "agent");
            xb_add(&bar[XB_XGEN(b.x)], 1u);
            asm volatile("s_waitcnt vmcnt(0)" ::: "memory");
        } else {
            XB_SPIN(xb_ld(&bar[XB_XGEN(b.x)]) == gen, bar);
            __builtin_amdgcn_fence(__ATOMIC_ACQUIRE, "agent");
            asm volatile("s_waitcnt vmcnt(0)" ::: "memory");
        }
    }
    __syncthreads();
}

struct Args {
    const float* in[20];
    float* out; unsigned char* ws;
    int ph_lo, ph_hi, coop, pad;
};
constexpr int N_PHASES = 11;

__global__ void __launch_bounds__(NTHREADS, 2) mega_fwd(Args args) {
    extern __shared__ __attribute__((aligned(16))) unsigned char lds_raw[];
    LAS unsigned char* lds = (LAS unsigned char*)lds_raw;
    const int tid = threadIdx.x, lane = tid & 63, wave = __builtin_amdgcn_readfirstlane(tid >> 6);
    const int G = gridDim.x, bx = blockIdx.x;
    const int gw = bx * NWAVES + wave, NGW = G * NWAVES;
    unsigned char* ws = args.ws;
    const float* x = args.in[0]; const float* cvec = args.in[1]; const float* w_ada = args.in[2]; const float* b_ada = args.in[3];
    const float* g_mix = args.in[4]; const float* w_in = args.in[5];
    const float* pos_k = args.in[6]; const float* cw1k = args.in[7]; const float* cw2k = args.in[8];
    const float* pos_v = args.in[9]; const float* cw1v = args.in[10]; const float* cw2v = args.in[11];
    const float* w_pa = args.in[12]; const float* w_pb = args.in[13]; const float* w_out = args.in[14];
    const float* g_ffn = args.in[15]; const float* w_gate = args.in[16]; const float* w_up = args.in[17]; const float* w_down = args.in[18];
    const float* g_fin = args.in[19];
    float* out = args.out;
    float* SUMSQ2 = (float*)(ws + WS_SUMSQ2); float* SUMSQ3 = (float*)(ws + WS_SUMSQ3);
    float* MOD = (float*)(ws + WS_MOD); float* BIASGU = (float*)(ws + WS_BIASGU);
    float* CB1 = (float*)(ws + 3 * MiB + 128 * 1024); float* CB1P = (float*)(ws + 3 * MiB + 192 * 1024);
    bf16_t* KC = (bf16_t*)(ws + WS_KC); bf16_t* VC = (bf16_t*)(ws + WS_VC);
    bf16_t* WIN = (bf16_t*)(ws + WS_WIN); bf16_t* WPA = (bf16_t*)(ws + WS_WPA); bf16_t* WPB = (bf16_t*)(ws + WS_WPB); bf16_t* WOUT = (bf16_t*)(ws + WS_WOUT);
    bf16_t* WGU = (bf16_t*)(ws + WS_WGU); bf16_t* WD = (bf16_t*)(ws + WS_WD);
    bf16_t* CW1K = (bf16_t*)(ws + WS_CW1K); bf16_t* CW1V = (bf16_t*)(ws + WS_CW1V); bf16_t* CW2K = (bf16_t*)(ws + WS_CW2K); bf16_t* CW2V = (bf16_t*)(ws + WS_CW2V);
    bf16_t* H = (bf16_t*)(ws + WS_H); bf16_t* Y = H;
    bf16_t* PROJ = (bf16_t*)(ws + WS_PROJ); bf16_t* ACT = PROJ;
    bf16_t* X1B = (bf16_t*)(ws + WS_PROJ + 200 * MiB);
    bf16_t* X2B = (bf16_t*)(ws + WS_H);
    bf16_t* OA = (bf16_t*)(ws + WS_OA); bf16_t* OB = (bf16_t*)(ws + WS_OB); bf16_t* APRE = OA;

    const int lo = args.ph_lo, hi = args.ph_hi;
#ifndef SB_VAR2
#define SB_VAR2 0
#endif
#ifndef REP_P0
#define REP_P0 1
#endif
#ifndef REP_P1
#define REP_P1 1
#endif
#ifndef REP_P2
#define REP_P2 1
#endif
#ifndef REP_P8
#define REP_P8 1
#endif
#ifndef REP_P3
#define REP_P3 1
#endif
#ifndef REP_NSA
#define REP_NSA 1
#endif
#ifndef REP_SB
#define REP_SB 1
#endif
#ifndef REP_SYNC
#define REP_SYNC 0
#endif
#ifndef SKIPMASK
#define SKIPMASK 0
#endif
#define IN(k) (lo <= (k) && (k) < hi && !((SKIPMASK >> (k)) & 1))
    volatile LAS unsigned* bst = (volatile LAS unsigned*)(lds + LDS_BYTES - 64);
    XcdBarrier bar; bar.bar = (unsigned*)(ws + 3 * MiB); bar.x = 0; bar.st = bst;
    if (args.coop) { if (tid < 2) bst[tid] = 0u; __syncthreads(); bar = xcd_barrier_post((unsigned*)(ws + 3 * MiB), bst); }
#define GRIDSYNC() do { if (args.pad == 0x7ffffff1) cg::this_grid().sync(); xcd_barrier(bar); } while (0)
#define SEAM(k) do { if (IN(k) && IN((k) + 1)) { GRIDSYNC(); } STAMP((k) + 1); } while (0)
#ifdef TS_PROBE
    unsigned long long* tsbuf = (unsigned long long*)(ws + 3 * MiB + 65536);
#define STAMP(k) do { if (bx == 0 && tid == 0) tsbuf[k] = __builtin_amdgcn_s_memrealtime(); } while (0)
#else
#define STAMP(k) do { } while (0)
#endif
    STAMP(0);

    if (IN(0)) {
        for (int i = bx * NTHREADS + tid; i < 65536; i += G * NTHREADS) SUMSQ2[i] = 0.f;
        LAS float* inl = (LAS float*)lds; LAS float* red = (LAS float*)(lds + 65536);
        if (bx < 192) {
            for (int i = tid; i < 16 * 1024; i += NTHREADS) { const int k = i >> 4, b = i & 15; const float v = cvec[b * DM + k]; inl[i] = v * sigmoidf_(v); }
            __syncthreads();
            for (int u = bx; u < 192; u += G) gemv16_unit(inl, red, w_ada, 6 * DM, 32 * u, b_ada, MOD, 6 * DM, OmId(), tid);
        }
        for (int i_ = G - 1 - bx; i_ < 64; i_ += G) {
            const int kv = i_ & 1, chunk = i_ >> 1; const float* pp = kv ? pos_v : pos_k; const float* ww = kv ? cw1v : cw1k;
            const int oc = tid & 127, part = tid >> 7; float s = 0.f;
#pragma unroll
            for (int k = chunk * 64 + part * 16; k < chunk * 64 + part * 16 + 16; ++k) s += pp[k] * ww[(size_t)k * 128 + oc];
            red[part * 128 + oc] = s;
            __syncthreads();
            if (tid < 128) CB1P[(chunk * 2 + kv) * 128 + tid] = (red[tid] + red[128 + tid]) + (red[256 + tid] + red[384 + tid]);
            __syncthreads();
        }
        __syncthreads();
        LAS float* scr = (LAS float*)(lds + wave * 8448);
        constexpr int I_WIN = 16 * 160, I_PA = 8 * 32, I_OUT = 16 * 32, I_G = 16 * 88, I_D = 44 * 32, I_C1 = 32 * 4, I_C2 = 2 * 2;
        constexpr int NITEMS = I_WIN + 2 * I_PA + I_OUT + 2 * I_G + I_D + 2 * I_C1 + 2 * I_C2;
        for (int it = gw; it < NITEMS; it += NGW) {
            int r = it;
            if (r < I_WIN) { transpose_item(w_in, DM, DIN, WIN, scr, r, 160, lane, MapWin()); continue; } r -= I_WIN;
            if (r < I_PA) { transpose_item(w_pa, 512, DM, WPA, scr, r, 32, lane, MapId()); continue; } r -= I_PA;
            if (r < I_PA) { transpose_item(w_pb, 512, DM, WPB, scr, r, 32, lane, MapId()); continue; } r -= I_PA;
            if (r < I_OUT) { transpose_item(w_out, DM, DM, WOUT, scr, r, 32, lane, MapId()); continue; } r -= I_OUT;
            if (r < I_G) { transpose_item(w_gate, DM, DFF, WGU, scr, r, 88, lane, MapGate()); continue; } r -= I_G;
            if (r < I_G) { transpose_item(w_up, DM, DFF, WGU, scr, r, 88, lane, MapUp()); continue; } r -= I_G;
            if (r < I_D) { transpose_item(w_down, DFF, DM, WD, scr, r, 32, lane, MapId()); continue; } r -= I_D;
            if (r < I_C1) { transpose_item(cw1k, 2048, 128, CW1K, scr, r, 4, lane, MapId()); continue; } r -= I_C1;
            if (r < I_C1) { transpose_item(cw1v, 2048, 128, CW1V, scr, r, 4, lane, MapId()); continue; } r -= I_C1;
            if (r < I_C2) { transpose_item(cw2k, 128, 64, CW2K, scr, r, 2, lane, MapId()); continue; } r -= I_C2;
            transpose_item(cw2v, 128, 64, CW2V, scr, r, 2, lane, MapId());
        }
    }
    SEAM(0);
    if (IN(1)) {
        if (bx < 176) {
            LAS float* inl = (LAS float*)lds; LAS float* red = (LAS float*)(lds + 65536);
            __syncthreads();
            for (int i = tid; i < 16 * 1024; i += NTHREADS) { const int k = i >> 4, b = i & 15; inl[i] = MOD[b * 6144 + 3 * DM + k]; }
            __syncthreads();
            for (int u = bx; u < 176; u += G) {
                if (u < 88) gemv16_unit(inl, red, w_gate, DFF, 32 * u, (const float*)nullptr, BIASGU, DGU, OmGate(), tid);
                else gemv16_unit(inl, red, w_up, DFF, 32 * (u - 88), (const float*)nullptr, BIASGU, DGU, OmUp(), tid);
            }
        }
        for (int kv = G - 1 - bx; kv < 2; kv += G) {

            if (tid < 128) { float s = 0.f;
#pragma unroll 8
                for (int cpart = 0; cpart < 32; ++cpart) s += CB1P[(cpart * 2 + kv) * 128 + tid];
                CB1[kv * 128 + tid] = s; }
        }
        unsigned* wq1 = (unsigned*)(ws + 3 * MiB + 15360 + 192);
        LAS unsigned* wql1 = (LAS unsigned*)(lds + LDS_BYTES - 32);
        unsigned nxt_ = 0u;
        if (tid == 0) nxt_ = __hip_atomic_fetch_add(wq1, 16u, __ATOMIC_RELAXED, __HIP_MEMORY_SCOPE_AGENT);
        for (;;) {
            __syncthreads();
            if (tid == 0) *wql1 = nxt_;
            __syncthreads();
            const int base_ = (int)*wql1;
            if (base_ >= MT) break;
            if (tid == 0) nxt_ = __hip_atomic_fetch_add(wq1, 16u, __ATOMIC_RELAXED, __HIP_MEMORY_SCOPE_AGENT);
        for (int m = base_ + 2 * wave; m < base_ + 2 * wave + 2; ++m) {
            const int b = m >> 11;
            const f32x4* xr = (const f32x4*)(x + (size_t)m * DM) + lane;
            f32x4 v[4]; float s = 0.f;
#pragma unroll
            for (int j = 0; j < 4; ++j) { v[j] = __builtin_nontemporal_load(xr + 64 * j); s += (v[j][0] * v[j][0] + v[j][1] * v[j][1]) + (v[j][2] * v[j][2] + v[j][3] * v[j][3]); }
            const float rstd = 1.0f / sqrtf(wave_sum(s) * (1.0f / DM) + RMS_EPS);
            u32x2* o8 = (u32x2*)(H + (size_t)m * DM) + lane;
#pragma unroll
            for (int j = 0; j < 4; ++j) {
                const int col = 4 * lane + 256 * j;
                const f32x4 gg = *(const f32x4*)(g_mix + col), sh = *(const f32x4*)(MOD + b * 6144 + col), sc = *(const f32x4*)(MOD + b * 6144 + DM + col);
                const f32x4 r = v[j] * rstd * gg * (sc + 1.0f) + sh;
                u32x2 w; w.x = cvtpk(r[0], r[1]); w.y = cvtpk(r[2], r[3]);
                o8[64 * j] = w;
            }
        }
        }
    }
    SEAM(1);
    if (IN(2)) {
        __syncthreads();
        pg8::Gemm g{H, WIN, MT, DINP, DM}; pg8::StaticOrder S; S.init(MT, DINP, G, bx);
        EpiProj E{PROJ};
        pg8::gemm_phase<EpiProj, pg8::StaticOrder, true, true>(lds, g, S, E);
    }
    SEAM(2);
    if (IN(3)) {
        __syncthreads();
        for (int rep_ = 0; rep_ < REP_P3; ++rep_)
        for (int u = bx; u < 256; u += G) {
            const int kv = u & 1, nq = (u >> 1) & 3, g = (u >> 3) & 1, b = u >> 4;
            compress_unit(lds, PROJ, CB1 + kv * 128, kv ? CW1V : CW1K, kv ? CW2V : CW2K, kv ? VC : KC, b, g, kv, nq, tid);
        }
    }
    SEAM(3);
    for (int rep_ = 0; rep_ < REP_SYNC; ++rep_) GRIDSYNC();
    if (IN(4)) {
        unsigned* wq = (unsigned*)(ws + 3 * MiB + 15360);
        LAS unsigned* wql = (LAS unsigned*)(lds + LDS_BYTES - 32);
        for (;;) {
            __syncthreads();
            if (tid == 0) *wql = __hip_atomic_fetch_add(wq, 1u, __ATOMIC_RELAXED, __HIP_MEMORY_SCOPE_AGENT);
            __syncthreads();
            const unsigned u = *wql;
            if (u >= 2048u) break;
            if (u < 1024u) { const int c = 31 - (int)(u >> 5), bg = (int)(u & 31u); nsa_unit(lds, PROJ, KC, VC, OA, bg >> 1, bg & 1, c, tid); }
            else { const unsigned i = u - 1024u; const int qb = 7 - (int)(i >> 7), bh = (int)(i & 127u); sb_unit<0>(lds, PROJ, OB, bh >> 3, bh & 7, qb, tid); }
        }
    }
    SEAM(4);
    if (IN(5)) {
        __syncthreads();
        pg8::Gemm g{OA, WPA, MT, DM, 512}; pg8::StaticOrder S; S.init(MT, DM, G, bx);
        EpiMerge<0> E{PROJ, Y};
        pg8::gemm_phase<EpiMerge<0>, pg8::StaticOrder, true, true>(lds, g, S, E);
    }
    STAMP(6);
    if (IN(6)) {
        __syncthreads();
        pg8::Gemm g{OB, WPB, MT, DM, 512}; pg8::StaticOrder S; S.init(MT, DM, G, bx);
        EpiMerge<1> E{PROJ, Y};
        pg8::gemm_phase<EpiMerge<1>, pg8::StaticOrder, true, true>(lds, g, S, E);
    }
    SEAM(6);
    if (IN(7)) {
        __syncthreads();
        pg8::Gemm g{Y, WOUT, MT, DM, DM}; pg8::StaticOrder S; S.init(MT, DM, G, bx);
        const bool alt = args.pad == 1;
        EpiOut E{x, alt ? (bf16_t*)(ws + WS_PROJ) : X1B, alt ? (bf16_t*)(ws + WS_PROJ + 64 * MiB) : APRE, MOD, g_ffn, alt ? (float*)(ws + WS_PROJ + 130 * MiB) : SUMSQ2};
        pg8::gemm_phase<EpiOut, pg8::StaticOrder, true, true>(lds, g, S, E);
    }
    SEAM(7);
    if (IN(8)) {
        __syncthreads();
        pg8::Gemm g{APRE, WGU, MT, DGU, DM}; pg8::StaticOrder S; S.init(MT, DGU, G, bx);
        EpiGU E{SUMSQ2, BIASGU, ACT};
        pg8::gemm_phase<EpiGU, pg8::StaticOrder, true, true>(lds, g, S, E);
    }
    SEAM(8);
    if (IN(9)) {
        __syncthreads();
        pg8::Gemm g{ACT, WD, MT, DM, DFF}; pg8::StaticOrder S; S.init(MT, DM, G, bx);
        const bool alt = args.pad == 1;
        EpiDown E{X1B, alt ? (bf16_t*)(ws + 400 * MiB) : X2B, MOD, alt ? (float*)(ws + 420 * MiB) : SUMSQ3};
        pg8::gemm_phase<EpiDown, pg8::StaticOrder, true, true>(lds, g, S, E);
    }
    SEAM(9);
    if (IN(10)) {
        for (int m = gw; m < MT; m += NGW) {
            const float rstd = 1.0f / sqrtf(SUMSQ3[m] * (1.0f / DM) + RMS_EPS);
            const u32x2* xr = (const u32x2*)(X2B + (size_t)m * DM) + lane;
            f32x4* xw = (f32x4*)((args.pad == 1 ? (float*)(ws + WS_PROJ) : out) + (size_t)m * DM) + lane;
            u32x2 xi[4];
#pragma unroll
            for (int j = 0; j < 4; ++j) xi[j] = __builtin_nontemporal_load(xr + 64 * j);
#pragma unroll
            for (int j = 0; j < 4; ++j) { const f32x4 gg = *(const f32x4*)(g_fin + 4 * lane + 256 * j);
                const f32x4 xv = {__uint_as_float(xi[j].x << 16), __uint_as_float(xi[j].x & 0xffff0000u), __uint_as_float(xi[j].y << 16), __uint_as_float(xi[j].y & 0xffff0000u)};
                __builtin_nontemporal_store(xv * rstd * gg, xw + 64 * j); }
        }
    }
    STAMP(11);
#ifdef TS_PROBE
    GRIDSYNC();
    if (bx == 0) {
        LAS float* lf = (LAS float*)lds;
        if (tid == 0) {
            const float v1 = (float)(tsbuf[TSA1] - tsbuf[TSA0]) * 0.1f;
            const float v2 = (float)(tsbuf[TSB1] - tsbuf[TSB0]) * 0.01f;
            out[0] = v1; lf[0] = v2;
        }
        __syncthreads();
        const float v2 = lf[0];
        for (int i = 1 + tid; i <= (1 << 20); i += NTHREADS) out[i] += v2;
    }
#endif
#undef IN
#undef SEAM
}

#ifndef MK_N_LAUNCHES
#define MK_N_LAUNCHES 1
#endif

extern "C" void kernel_launch(void* const* d_in, const int* in_sizes, int n_in, void* d_out, int out_size, void* d_ws, size_t ws_size, hipStream_t stream) {
    static int grid = 0;
    if (grid == 0) {
        if (n_in != 20 || out_size != MT * DM || ws_size < WS_END) { fprintf(stderr, "kernel_launch: unexpected shapes n_in %d out %d ws %zu\n", n_in, out_size, ws_size); grid = -1; return; }
        int dev = 0, cus = 0, per_cu = 0;
        hipGetDevice(&dev);
        hipDeviceGetAttribute(&cus, hipDeviceAttributeMultiprocessorCount, dev);
        if (hipFuncSetAttribute((const void*)mega_fwd, hipFuncAttributeMaxDynamicSharedMemorySize, LDS_BYTES) != hipSuccess) { fprintf(stderr, "kernel_launch: hipFuncSetAttribute failed\n"); grid = -1; return; }
        if (hipOccupancyMaxActiveBlocksPerMultiprocessor(&per_cu, (const void*)mega_fwd, NTHREADS, LDS_BYTES) != hipSuccess || per_cu < 1) { fprintf(stderr, "kernel_launch: occupancy query gave %d\n", per_cu); per_cu = 1; }
        (void)hipGetLastError();
        grid = cus * 1;
        if (grid <= 0) grid = 256;
    }
    if (grid < 0) return;
    if (hipMemsetAsync((char*)d_ws + 3 * MiB, 0, 16384, stream) != hipSuccess) { fprintf(stderr, "kernel_launch: memset failed\n"); return; }
    Args a{};
    for (int i = 0; i < 20; ++i) a.in[i] = (const float*)d_in[i];
    a.out = (float*)d_out; a.ws = (unsigned char*)d_ws;
#if MK_N_LAUNCHES == 1
    a.ph_lo = 0; a.ph_hi = N_PHASES; a.coop = 1; a.pad = 0;
    void* kargs[] = {&a};
    hipError_t e = hipLaunchCooperativeKernel((const void*)mega_fwd, dim3(grid), dim3(NTHREADS), kargs, LDS_BYTES, stream);
    if (e != hipSuccess) fprintf(stderr, "kernel_launch: cooperative launch failed: %s (grid %d)\n", hipGetErrorString(e), grid);
#else
    const int cuts[] = {0, 1, 2, 3, 4, 5, 7, 8, 9, 10, 11};
    for (int li = 0; li + 1 < (int)(sizeof(cuts) / sizeof(int)); ++li) {
        a.ph_lo = cuts[li]; a.ph_hi = cuts[li + 1]; a.coop = 0; a.pad = 0;
        hipLaunchKernelGGL(mega_fwd, dim3(grid), dim3(NTHREADS), LDS_BYTES, stream, a);
#ifdef DUP_PHASE
        if (cuts[li] == DUP_PHASE) { a.pad = 1; hipLaunchKernelGGL(mega_fwd, dim3(grid), dim3(NTHREADS), LDS_BYTES, stream, a); a.pad = 0; }
        if (DUP_PHASE == 99 && li == 0) { a.ph_lo = 0; a.ph_hi = 0; hipLaunchKernelGGL(mega_fwd, dim3(grid), dim3(NTHREADS), LDS_BYTES, stream, a); }
#endif
    }
#endif
}
```

```cpp
#include <hip/hip_runtime.h>
#include <hip/hip_cooperative_groups.h>
#include <cstdio>
#include <cstdint>
#include <cmath>
namespace cg = cooperative_groups;
namespace pg8 {
#define PG8_LAS __attribute__((address_space(3)))
typedef unsigned short bf16_t;
typedef short bf16x8 __attribute__((ext_vector_type(8)));
typedef float f32x4 __attribute__((ext_vector_type(4)));
typedef unsigned u32x4 __attribute__((ext_vector_type(4)));
constexpr int BM = 256, BK = 64, HALF = 128, HTB = HALF * BK * 2  , STAGE_BYTES = 8 * HTB, NXCD = 8, WGM = 8;

__host__ __device__ __forceinline__ int lds_byte(int r, int c) { const int st = (r >> 4) * 2 + (c >> 5), rr = r & 15, cc = c & 31, ob = rr * 64 + cc * 2; return st * 1024 + (ob ^ (((ob >> 9) & 1) << 5)); }
__host__ __device__ __forceinline__ void stage_rc(int b, int& R, int& C) { const int st = b / 1024, sb = b % 1024, swz = sb ^ (((sb >> 9) & 1) << 5); R = (st >> 1) * 16 + swz / 64; C = (st & 1) * 32 + (swz % 64) / 2; }
__host__ __device__ __forceinline__ int perm32(int rho) { const int n = rho >> 4, i = rho & 15; return 8 * (i >> 2) + 4 * n + (i & 3); }

struct Unit { int pm, pn; };
struct Gemm { const bf16_t* A; const bf16_t* Bt; int M, N, K; };

struct StaticOrder {
    int nM, nN, nwg, G, c;
    __host__ __device__ void init(int M, int N, int G_, int c_) { nM = M / BM; nN = N / BM; nwg = nM * nN; G = G_; c = c_; }
    __host__ __device__ bool next(int i, Unit& u) const {
        const long L = (long)i * G + c; if (L >= nwg) return false;
        int wgid = (int)L; { const int q = nwg / NXCD, r = nwg % NXCD, xcd = wgid % NXCD, off = wgid / NXCD; wgid = (xcd < r ? xcd * (q + 1) : r * (q + 1) + (xcd - r) * q) + off; }
        const int nig = WGM * nN, gid = wgid / nig, fm = gid * WGM, gsz = (nM - fm) < WGM ? (nM - fm) : WGM;
        u.pm = fm + ((wgid % nig) % gsz); u.pn = (wgid % nig) / gsz; return true;
    }
    __device__ __forceinline__ void a_ready(const Unit&) const {}
    __device__ __forceinline__ void done(const Unit&) const {}
};

__device__ __forceinline__ unsigned cvt_pk_bf16(float lo, float hi) { unsigned r; asm volatile("v_cvt_pk_bf16_f32 %0, %1, %2" : "=v"(r) : "v"(lo), "v"(hi)); return r; }
template <class Epi, class Sched, bool ALIGN_EPI = false, bool SP2 = false>
__device__ __forceinline__ void gemm_phase(PG8_LAS unsigned char* lds, const Gemm g, const Sched& S, const Epi& E) {
    const int tid = threadIdx.x, wid = __builtin_amdgcn_readfirstlane(tid >> 6), lane = tid & 63, wr = wid >> 2, wc = wid & 3, fr = lane & 15, fq = lane >> 4;
    const int K = g.K, nt = K / BK;
    unsigned voffA[2], voffB[2];
#pragma unroll
    for (int i = 0; i < 2; ++i) { int R, C; stage_rc(tid * 16 + i * 8192, R, C); const int Rb = Epi::PERM ? ((R & ~31) + perm32(R & 31)) : R;
        voffA[i] = (unsigned)(R * K + C) * 2u; voffB[i] = (unsigned)(Rb * K + C) * 2u; }
    const size_t kstep = (size_t)(BK * 2);
    const size_t hstep = (size_t)HALF * K * 2;
    const size_t tstep = 2 * hstep;
    const unsigned ldsw = (unsigned)wid * 1024u;
    const int aoff = lds_byte(wr * 64 + fr, fq * 8), boff = lds_byte(wc * 32 + fr, fq * 8);
#define PG8_SA(b, h) (((b) * 2 + (h)) * HTB)
#define PG8_SB(b, h) ((4 + (b) * 2 + (h)) * HTB)
#define PG8_STAGE(bufoff, gbase, voff) do { _Pragma("unroll") for (int _i = 0; _i < 2; ++_i) \
        __builtin_amdgcn_global_load_lds((const unsigned*)((const char*)(gbase) + (voff)[_i]), (PG8_LAS unsigned*)(lds + (bufoff) + ldsw + _i * 8192), 16, 0, 0); } while (0)
#define PG8_LDA(dst, b, h) do { _Pragma("unroll") for (int m = 0; m < 4; ++m) _Pragma("unroll") for (int k = 0; k < 2; ++k) dst[m][k] = *(const PG8_LAS bf16x8*)(lds + PG8_SA(b, h) + aoff + m * 2048 + k * 1024); } while (0)
#define PG8_LDB(dst, b, h) do { _Pragma("unroll") for (int n = 0; n < 2; ++n) _Pragma("unroll") for (int k = 0; k < 2; ++k) dst[n][k] = *(const PG8_LAS bf16x8*)(lds + PG8_SB(b, h) + boff + n * 2048 + k * 1024); } while (0)
#define PG8_MMA(ai, bj, At, Bt) do { __builtin_amdgcn_s_setprio(1); _Pragma("unroll") for (int m = 0; m < 4; ++m) _Pragma("unroll") for (int n = 0; n < 2; ++n) _Pragma("unroll") for (int k = 0; k < 2; ++k) \
        acc[ai][bj][m][n] = __builtin_amdgcn_mfma_f32_16x16x32_bf16(Bt[n][k], At[m][k], acc[ai][bj][m][n], 0, 0, 0); __builtin_amdgcn_s_setprio(0); } while (0)
#define PG8_WAIT_V(n) asm volatile("s_waitcnt vmcnt(" #n ")" ::: "memory")
#define PG8_WAIT_L(n) asm volatile("s_waitcnt lgkmcnt(" #n ")" ::: "memory")
#define PG8_BAR __builtin_amdgcn_s_barrier()
#define PG8_SCHED __builtin_amdgcn_sched_barrier(0)
    Unit cur, nxt; int ui = 0;
    if (!S.next(0, cur)) return;
    f32x4 acc[2][2][4][2];
#pragma unroll
    for (int a = 0; a < 2; ++a)
#pragma unroll
        for (int b = 0; b < 2; ++b)
#pragma unroll
            for (int m = 0; m < 4; ++m)
#pragma unroll
                for (int n = 0; n < 2; ++n) acc[a][b][m][n] = (f32x4){0.f, 0.f, 0.f, 0.f};
    bf16x8 At[4][2], B0[2][2], B1[2][2];
    const char* cA = (const char*)g.A + (size_t)cur.pm * tstep; const char* cB = (const char*)g.Bt + (size_t)cur.pn * tstep;
    S.a_ready(cur);
    if constexpr (SP2) {
        PG8_STAGE(PG8_SB(0, 0), cB, voffB); PG8_STAGE(PG8_SB(0, 1), cB + hstep, voffB); PG8_STAGE(PG8_SA(0, 0), cA, voffA); PG8_STAGE(PG8_SA(0, 1), cA + hstep, voffA);
        if (wr == 1) PG8_BAR;
        PG8_WAIT_V(2); PG8_BAR;
        PG8_STAGE(PG8_SB(1, 0), cB + kstep, voffB); PG8_STAGE(PG8_SA(1, 0), cA + kstep, voffA); PG8_STAGE(PG8_SB(1, 1), cB + hstep + kstep, voffB);
        PG8_WAIT_V(6); PG8_BAR;
    } else {
        PG8_STAGE(PG8_SB(0, 0), cB, voffB); PG8_STAGE(PG8_SA(0, 0), cA, voffA); PG8_STAGE(PG8_SB(0, 1), cB + hstep, voffB); PG8_STAGE(PG8_SA(0, 1), cA + hstep, voffA);
        if (wr == 1) PG8_BAR;
        PG8_WAIT_V(4); PG8_BAR;
        PG8_STAGE(PG8_SB(1, 0), cB + kstep, voffB); PG8_STAGE(PG8_SA(1, 0), cA + kstep, voffA); PG8_STAGE(PG8_SB(1, 1), cB + hstep + kstep, voffB);
        PG8_WAIT_V(6); PG8_BAR;
    }
    for (;;) {
        const bool has_next = S.next(ui + 1, nxt);
        const char* nA = has_next ? (const char*)g.A + (size_t)nxt.pm * tstep : cA; const char* nB = has_next ? (const char*)g.Bt + (size_t)nxt.pn * tstep : cB;
        for (int t = 0; t < nt; t += 2) {
            const bool last = (t == nt - 2);
            const char* a1 = cA + (size_t)(t + 1) * kstep;
            const char* a2 = last ? nA : cA + (size_t)(t + 2) * kstep; const char* b2 = last ? nB : cB + (size_t)(t + 2) * kstep;
            const char* a3 = a2 + kstep; const char* b3 = b2 + kstep;
            if (last && has_next) S.a_ready(nxt);
            if constexpr (SP2) {
            PG8_LDB(B0, 0, 0); PG8_LDB(B1, 0, 1); PG8_SCHED; PG8_LDA(At, 0, 0); PG8_STAGE(PG8_SA(1, 1), a1 + hstep, voffA);
            PG8_WAIT_V(8); PG8_WAIT_L(0); PG8_BAR; PG8_MMA(0, 0, At, B0); PG8_MMA(0, 1, At, B1); PG8_BAR; PG8_SCHED;
            PG8_LDA(At, 0, 1); PG8_STAGE(PG8_SB(0, 0), b2, voffB); PG8_STAGE(PG8_SB(0, 1), b2 + hstep, voffB); PG8_STAGE(PG8_SA(0, 0), a2, voffA);
            PG8_WAIT_V(8); PG8_WAIT_L(0); PG8_BAR; PG8_MMA(1, 0, At, B0); PG8_MMA(1, 1, At, B1); PG8_BAR; PG8_SCHED;
            PG8_LDB(B0, 1, 0); PG8_LDB(B1, 1, 1); PG8_SCHED; PG8_LDA(At, 1, 0); PG8_STAGE(PG8_SA(0, 1), a2 + hstep, voffA);
            PG8_WAIT_V(8); PG8_WAIT_L(0); PG8_BAR; PG8_MMA(0, 0, At, B0); PG8_MMA(0, 1, At, B1); PG8_BAR; PG8_SCHED;
            PG8_LDA(At, 1, 1); PG8_STAGE(PG8_SB(1, 0), b3, voffB); PG8_STAGE(PG8_SB(1, 1), b3 + hstep, voffB); PG8_STAGE(PG8_SA(1, 0), a3, voffA);
            PG8_WAIT_V(8); PG8_WAIT_L(0); PG8_BAR; PG8_MMA(1, 0, At, B0); PG8_MMA(1, 1, At, B1); PG8_BAR; PG8_SCHED;
            } else {
            PG8_LDB(B0, 0, 0); PG8_SCHED; PG8_LDA(At, 0, 0); PG8_STAGE(PG8_SA(1, 1), a1 + hstep, voffA);
            PG8_WAIT_L(8); PG8_BAR; PG8_WAIT_L(0); PG8_MMA(0, 0, At, B0); PG8_BAR; PG8_SCHED;
            PG8_LDB(B1, 0, 1); PG8_STAGE(PG8_SB(0, 0), b2, voffB);
            PG8_BAR; PG8_WAIT_L(0); PG8_MMA(0, 1, At, B1); PG8_BAR;
            PG8_LDA(At, 0, 1); PG8_STAGE(PG8_SA(0, 0), a2, voffA);
            PG8_BAR; PG8_WAIT_L(0); PG8_MMA(1, 0, At, B0); PG8_BAR; PG8_SCHED;
            PG8_STAGE(PG8_SB(0, 1), b2 + hstep, voffB);
            PG8_WAIT_V(6); PG8_BAR; PG8_MMA(1, 1, At, B1); PG8_BAR;
            PG8_LDB(B0, 1, 0); PG8_SCHED; PG8_LDA(At, 1, 0); PG8_STAGE(PG8_SA(0, 1), a2 + hstep, voffA);
            PG8_WAIT_L(8); PG8_BAR; PG8_WAIT_L(0); PG8_MMA(0, 0, At, B0); PG8_BAR; PG8_SCHED;
            PG8_LDB(B1, 1, 1); PG8_STAGE(PG8_SB(1, 0), b3, voffB);
            PG8_BAR; PG8_WAIT_L(0); PG8_MMA(0, 1, At, B1); PG8_BAR;
            PG8_LDA(At, 1, 1); PG8_STAGE(PG8_SA(1, 0), a3, voffA);
            PG8_BAR; PG8_WAIT_L(0); PG8_MMA(1, 0, At, B0); PG8_BAR; PG8_SCHED;
            PG8_STAGE(PG8_SB(1, 1), b3 + hstep, voffB);
            PG8_WAIT_V(6); PG8_BAR; PG8_MMA(1, 1, At, B1); PG8_BAR;
            }
        }
        if constexpr (ALIGN_EPI) { if (wr == 0) PG8_BAR; }
        if constexpr (!Epi::AFTER_DRAIN) { E(acc, cur, wr, wc, fr, fq); S.done(cur); }
        if (!has_next) break;
#pragma unroll
        for (int a = 0; a < 2; ++a)
#pragma unroll
            for (int b = 0; b < 2; ++b)
#pragma unroll
                for (int m = 0; m < 4; ++m)
#pragma unroll
                    for (int n = 0; n < 2; ++n) acc[a][b][m][n] = (f32x4){0.f, 0.f, 0.f, 0.f};
        cur = nxt; cA = nA; cB = nB; ++ui;
        if constexpr (ALIGN_EPI) { if (wr == 1) PG8_BAR; }
    }
    PG8_WAIT_V(0);
    if constexpr (!ALIGN_EPI) { if (wr == 0) PG8_BAR; }
    PG8_BAR;
    if constexpr (Epi::AFTER_DRAIN) { E.fused(acc, cur, wr, wc, fr, fq, lds, wid, lane); S.done(cur); }
#undef PG8_SA
#undef PG8_SB
#undef PG8_STAGE
#undef PG8_LDA
#undef PG8_LDB
#undef PG8_MMA
#undef PG8_WAIT_V
#undef PG8_WAIT_L
#undef PG8_BAR
#undef PG8_SCHED
}
}

#define LAS __attribute__((address_space(3)))
#define DI __device__ __forceinline__
typedef unsigned short bf16_t;
typedef short bf16x8 __attribute__((ext_vector_type(8)));
typedef float f32x4 __attribute__((ext_vector_type(4)));
typedef float f32x16 __attribute__((ext_vector_type(16)));
typedef unsigned u32x4 __attribute__((ext_vector_type(4)));
typedef unsigned u32x2 __attribute__((ext_vector_type(2)));
typedef float f32x2_t __attribute__((ext_vector_type(2)));
typedef __bf16 bf16x2_t __attribute__((ext_vector_type(2)));

constexpr int NB = 16, SEQ = 2048, DM = 1024, MT = NB * SEQ;
constexpr int DIN = 4888, DINP = 5120, DFF = 2816, DGU = 2 * DFF;
constexpr int C_QA = 0, C_KVA = 512, C_GA = 1280, C_QB = 1304, C_KB = 1816, C_VB = 2328, C_MG = 2840;
constexpr float LOG2E = 1.4426950408889634f;
constexpr float QSCALE = 0.125f * LOG2E;
constexpr float RMS_EPS = 1e-6f;
constexpr int NWAVES = 8, NTHREADS = 512;
constexpr int LDS_BYTES = 147456;

constexpr size_t MiB = 1u << 20;
constexpr size_t WS_SUMSQ2 = 0, WS_SUMSQ3 = 128 * 1024, WS_MOD = 256 * 1024, WS_BIASGU = 1 * MiB, WS_KC = 2 * MiB, WS_VC = 2 * MiB + 512 * 1024;
constexpr size_t WS_WIN = 4 * MiB, WS_WPA = 14 * MiB, WS_WPB = 15 * MiB, WS_WOUT = 16 * MiB, WS_WGU = 18 * MiB, WS_WD = 29 * MiB;
constexpr size_t WS_CW1K = 35 * MiB, WS_CW1V = 35 * MiB + 512 * 1024, WS_CW2K = 36 * MiB, WS_CW2V = 36 * MiB + 64 * 1024;
constexpr size_t WS_H = 40 * MiB;
constexpr size_t WS_PROJ = 104 * MiB;
constexpr size_t WS_OA = 424 * MiB, WS_OB = 456 * MiB;
constexpr size_t WS_END = 488 * MiB;

DI float bf2f(unsigned short v) { return __uint_as_float((unsigned)v << 16); }
DI unsigned cvtpk(float lo, float hi) { f32x2_t v = {lo, hi}; bf16x2_t b = __builtin_convertvector(v, bf16x2_t); return __builtin_bit_cast(unsigned, b); }
DI float fast_exp2(float x) { return __builtin_amdgcn_exp2f(x); }
DI float fast_log2(float x) { return __builtin_amdgcn_logf(x); }
DI float fast_rcp(float x) { return __builtin_amdgcn_rcpf(x); }
DI float sigmoidf_(float x) { return fast_rcp(1.0f + fast_exp2(-x * LOG2E)); }
DI float wave_sum(float v) {
#pragma unroll
    for (int o = 1; o < 64; o <<= 1) v += __shfl_xor(v, o);
    return v;
}
#define LDS_WAIT() asm volatile("s_waitcnt lgkmcnt(0)" ::: "memory")

using pg8::Unit;
struct EpiProj {
    static constexpr bool PERM = true, AFTER_DRAIN = false;
    bf16_t* O;
    DI void operator()(const f32x4 (&acc)[2][2][4][2], const Unit& u, int wr, int wc, int fr, int fq) const {
        const int row0 = u.pm * 256 + wr * 64 + fr, colb = u.pn * 256 + wc * 32 + 8 * fq;
#pragma unroll
        for (int ai = 0; ai < 2; ++ai)
#pragma unroll
            for (int m = 0; m < 4; ++m) {
                bf16_t* rowp = O + (size_t)(row0 + ai * 128 + m * 16) * DINP + colb;
#pragma unroll
                for (int bj = 0; bj < 2; ++bj) {
                    const int col = colb + bj * 128;
                    const bool sg = (col >= C_GA && col < C_QB) || (col >= C_MG);
                    f32x4 v0 = acc[ai][bj][m][0], v1 = acc[ai][bj][m][1];
                    if (sg) {
#pragma unroll
                        for (int e = 0; e < 4; ++e) { v0[e] = sigmoidf_(v0[e]); v1[e] = sigmoidf_(v1[e]); }
                    }
                    u32x4 w; w.x = cvtpk(v0[0], v0[1]); w.y = cvtpk(v0[2], v0[3]); w.z = cvtpk(v1[0], v1[1]); w.w = cvtpk(v1[2], v1[3]);
                    *(u32x4*)(rowp + bj * 128) = w;
                }
            }
    }
};
template <int PASS> struct EpiMerge {
    static constexpr bool PERM = true, AFTER_DRAIN = false;
    const bf16_t* __restrict__ proj; bf16_t* Y;
    DI void operator()(const f32x4 (&acc)[2][2][4][2], const Unit& u, int wr, int wc, int fr, int fq) const {
        const int row0 = u.pm * 256 + wr * 64 + fr, colb = u.pn * 256 + wc * 32 + 8 * fq;
#pragma unroll
        for (int ai = 0; ai < 2; ++ai) {
            u32x4 mg[4][2], pv[4][2];
#pragma unroll
            for (int m = 0; m < 4; ++m)
#pragma unroll
                for (int bj = 0; bj < 2; ++bj) {
                    const size_t row = (size_t)(row0 + ai * 128 + m * 16); const int col = colb + bj * 128;
                    mg[m][bj] = *(const u32x4*)(proj + row * DINP + C_MG + PASS * DM + col);
                    if (PASS == 1) pv[m][bj] = *(const u32x4*)(Y + row * DM + col);
                }
#pragma unroll
            for (int m = 0; m < 4; ++m)
#pragma unroll
                for (int bj = 0; bj < 2; ++bj) {
                    const size_t row = (size_t)(row0 + ai * 128 + m * 16); const int col = colb + bj * 128;
                    const u32x4 g = mg[m][bj];
                    f32x4 v0 = acc[ai][bj][m][0], v1 = acc[ai][bj][m][1];
                    v0[0] *= __uint_as_float(g.x << 16); v0[1] *= __uint_as_float(g.x & 0xffff0000u);
                    v0[2] *= __uint_as_float(g.y << 16); v0[3] *= __uint_as_float(g.y & 0xffff0000u);
                    v1[0] *= __uint_as_float(g.z << 16); v1[1] *= __uint_as_float(g.z & 0xffff0000u);
                    v1[2] *= __uint_as_float(g.w << 16); v1[3] *= __uint_as_float(g.w & 0xffff0000u);
                    if (PASS == 1) {
                        const u32x4 q = pv[m][bj];
                        v0[0] += __uint_as_float(q.x << 16); v0[1] += __uint_as_float(q.x & 0xffff0000u);
                        v0[2] += __uint_as_float(q.y << 16); v0[3] += __uint_as_float(q.y & 0xffff0000u);
                        v1[0] += __uint_as_float(q.z << 16); v1[1] += __uint_as_float(q.z & 0xffff0000u);
                        v1[2] += __uint_as_float(q.w << 16); v1[3] += __uint_as_float(q.w & 0xffff0000u);
                    }
                    u32x4 w; w.x = cvtpk(v0[0], v0[1]); w.y = cvtpk(v0[2], v0[3]); w.z = cvtpk(v1[0], v1[1]); w.w = cvtpk(v1[2], v1[3]);
                    *(u32x4*)(Y + row * DM + col) = w;
                }
        }
    }
};
struct EpiOut {
    static constexpr bool PERM = false, AFTER_DRAIN = false;
    const float* x; bf16_t* x1; bf16_t* apre; const float* mod; const float* gffn; float* sumsq;
    DI void operator()(const f32x4 (&acc)[2][2][4][2], const Unit& u, int wr, int wc, int fr, int fq) const {
        const int b = u.pm >> 3, colb = u.pn * 256 + wc * 32 + 4 * fq;
        f32x4 g1v[2][2], mul[2][2];
#pragma unroll
        for (int bj = 0; bj < 2; ++bj)
#pragma unroll
            for (int n = 0; n < 2; ++n) {
                const int col = colb + bj * 128 + n * 16;
                g1v[bj][n] = *(const f32x4*)(mod + b * 6144 + 2 * DM + col);
                const f32x4 sc = *(const f32x4*)(mod + b * 6144 + 4 * DM + col), gg = *(const f32x4*)(gffn + col);
                mul[bj][n] = gg * (sc + 1.0f);
            }
#pragma unroll
        for (int ai = 0; ai < 2; ++ai)
#pragma unroll
          for (int mh = 0; mh < 2; ++mh) {
            f32x4 xin[2][2][2];
#pragma unroll
            for (int mm = 0; mm < 2; ++mm)
#pragma unroll
                for (int bj = 0; bj < 2; ++bj)
#pragma unroll
                    for (int n = 0; n < 2; ++n) xin[mm][bj][n] = __builtin_nontemporal_load((const f32x4*)(x + (size_t)(u.pm * 256 + ai * 128 + wr * 64 + (2 * mh + mm) * 16 + fr) * DM + colb + bj * 128 + n * 16));
#pragma unroll
            for (int mm = 0; mm < 2; ++mm) {
                const int m = 2 * mh + mm;
                const size_t row = (size_t)(u.pm * 256 + ai * 128 + wr * 64 + m * 16 + fr);
                float ss = 0.f;
#pragma unroll
                for (int bj = 0; bj < 2; ++bj)
#pragma unroll
                    for (int n = 0; n < 2; ++n) {
                        const size_t off = row * DM + colb + bj * 128 + n * 16;
                        const f32x4 xv = xin[mm][bj][n];
                        const f32x4 v = xv + g1v[bj][n] * acc[ai][bj][m][n];
                        { u32x2 wv; wv.x = cvtpk(v[0], v[1]); wv.y = cvtpk(v[2], v[3]); *(u32x2*)(x1 + off) = wv; }
                        ss += (v[0] * v[0] + v[1] * v[1]) + (v[2] * v[2] + v[3] * v[3]);
                        const f32x4 a = v * mul[bj][n];
                        u32x2 w; w.x = cvtpk(a[0], a[1]); w.y = cvtpk(a[2], a[3]);
                        *(u32x2*)(apre + off) = w;
                    }
                ss += __shfl_xor(ss, 16); ss += __shfl_xor(ss, 32);
                if (fq == 0) atomicAdd(sumsq + row, ss);
            }
          }
    }
};
struct EpiGU {
    static constexpr bool PERM = true, AFTER_DRAIN = false;
    const float* sumsq; const float* biasgu; bf16_t* act;
    DI void operator()(const f32x4 (&acc)[2][2][4][2], const Unit& u, int wr, int wc, int fr, int fq) const {
        const int b = u.pm >> 3, colb = u.pn * 256 + wc * 32 + 8 * fq;
        f32x4 bg[2], bu[2];
#pragma unroll
        for (int bj = 0; bj < 2; ++bj) { bg[bj] = *(const f32x4*)(biasgu + b * DGU + colb + bj * 128); bu[bj] = *(const f32x4*)(biasgu + b * DGU + colb + bj * 128 + 4); }
#pragma unroll
        for (int ai = 0; ai < 2; ++ai)
#pragma unroll
            for (int m = 0; m < 4; ++m) {
                const size_t row = (size_t)(u.pm * 256 + ai * 128 + wr * 64 + m * 16 + fr);
                const float rstd = 1.0f / sqrtf(sumsq[row] * (1.0f / DM) + RMS_EPS);
#pragma unroll
                for (int bj = 0; bj < 2; ++bj) {
                    const f32x4 gv = acc[ai][bj][m][0] * rstd + bg[bj], uv = acc[ai][bj][m][1] * rstd + bu[bj];
                    float a[4];
#pragma unroll
                    for (int e = 0; e < 4; ++e) a[e] = gv[e] * sigmoidf_(gv[e]) * uv[e];
                    u32x2 w; w.x = cvtpk(a[0], a[1]); w.y = cvtpk(a[2], a[3]);
                    *(u32x2*)(act + row * DFF + ((colb + bj * 128) >> 1)) = w;
                }
            }
    }
};
struct EpiDown {
    static constexpr bool PERM = false, AFTER_DRAIN = false;
    const bf16_t* xio; bf16_t* xout; const float* mod; float* sumsq;
    DI void operator()(const f32x4 (&acc)[2][2][4][2], const Unit& u, int wr, int wc, int fr, int fq) const {
        const int b = u.pm >> 3, colb = u.pn * 256 + wc * 32 + 4 * fq;
        f32x4 g2v[2][2];
#pragma unroll
        for (int bj = 0; bj < 2; ++bj)
#pragma unroll
            for (int n = 0; n < 2; ++n) g2v[bj][n] = *(const f32x4*)(mod + b * 6144 + 5 * DM + colb + bj * 128 + n * 16);
#pragma unroll
        for (int ai = 0; ai < 2; ++ai)
#pragma unroll
          for (int mh = 0; mh < 2; ++mh) {
            u32x2 xin[2][2][2];
#pragma unroll
            for (int mm = 0; mm < 2; ++mm)
#pragma unroll
                for (int bj = 0; bj < 2; ++bj)
#pragma unroll
                    for (int n = 0; n < 2; ++n) xin[mm][bj][n] = *(const u32x2*)(xio + (size_t)(u.pm * 256 + ai * 128 + wr * 64 + (2 * mh + mm) * 16 + fr) * DM + colb + bj * 128 + n * 16);
#pragma unroll
            for (int mm = 0; mm < 2; ++mm) {
                const int m = 2 * mh + mm;
                const size_t row = (size_t)(u.pm * 256 + ai * 128 + wr * 64 + m * 16 + fr);
                float ss = 0.f;
#pragma unroll
                for (int bj = 0; bj < 2; ++bj)
#pragma unroll
                    for (int n = 0; n < 2; ++n) {
                        const size_t off = row * DM + colb + bj * 128 + n * 16;
                        const u32x2 xi = xin[mm][bj][n];
                        const f32x4 xv = {__uint_as_float(xi.x << 16), __uint_as_float(xi.x & 0xffff0000u), __uint_as_float(xi.y << 16), __uint_as_float(xi.y & 0xffff0000u)};
                        const f32x4 v = xv + g2v[bj][n] * acc[ai][bj][m][n];
                        { u32x2 wv; wv.x = cvtpk(v[0], v[1]); wv.y = cvtpk(v[2], v[3]); *(u32x2*)(xout + off) = wv; }
                        ss += (v[0] * v[0] + v[1] * v[1]) + (v[2] * v[2] + v[3] * v[3]);
                    }
                ss += __shfl_xor(ss, 16); ss += __shfl_xor(ss, 32);
                if (fq == 0) atomicAdd(sumsq + row, ss);
            }
          }
    }
};

template <class F>
DI void transpose_item(const float* __restrict__ W, int K, int N, bf16_t* WT, LAS float* scr, int item, int nblk, int lane, F f) {
    const int kb = item / nblk, nb = item % nblk, k0 = 64 * kb, n0 = 32 * nb;
    const int nn = n0 + (lane & 31);
#pragma unroll
    for (int i = 0; i < 32; ++i) { const int kk = 2 * i + (lane >> 5); scr[kk * 33 + (lane & 31)] = (nn < N) ? W[(size_t)(k0 + kk) * N + nn] : 0.f; }
    LDS_WAIT(); asm volatile("" ::: "memory");
    const int c = lane & 7;
#pragma unroll
    for (int j = 0; j < 4; ++j) {
        const int nl = (lane >> 3) + 8 * j; int row; float sc; f(n0 + nl, row, sc);
        const LAS float* s = scr + (8 * c) * 33 + nl;
        u32x4 o; o.x = cvtpk(s[0 * 33] * sc, s[1 * 33] * sc); o.y = cvtpk(s[2 * 33] * sc, s[3 * 33] * sc); o.z = cvtpk(s[4 * 33] * sc, s[5 * 33] * sc); o.w = cvtpk(s[6 * 33] * sc, s[7 * 33] * sc);
        *(u32x4*)(WT + (size_t)row * K + k0 + 8 * c) = o;
    }
    LDS_WAIT(); asm volatile("" ::: "memory");
}
struct MapId { DI void operator()(int n, int& row, float& sc) const { row = n; sc = 1.f; } };
struct MapWin { DI void operator()(int n, int& row, float& sc) const { row = n; sc = (n < 512 || (n >= C_QB && n < C_KB)) ? QSCALE : 1.f; } };
struct MapGate { DI void operator()(int n, int& row, float& sc) const { row = 8 * (n >> 2) + (n & 3); sc = 1.f; } };
struct MapUp { DI void operator()(int n, int& row, float& sc) const { row = 8 * (n >> 2) + 4 + (n & 3); sc = 1.f; } };

template <class OM>
DI void gemv16_unit(const LAS float* inl, LAS float* red, const float* __restrict__ W, int ldw, int col0, const float* bias, float* out, int ldo, OM om, int tid) {
    const int cl = tid & 31, kg = tid >> 5;
    float acc[16];
#pragma unroll
    for (int b = 0; b < 16; ++b) acc[b] = 0.f;
    const float* wp = W + (size_t)(kg * 64) * ldw + col0 + cl;
#pragma unroll 4
    for (int kk = 0; kk < 64; ++kk) {
        const float w = wp[(size_t)kk * ldw];
        const LAS f32x4* ip = (const LAS f32x4*)(inl + (kg * 64 + kk) * 16);
        const f32x4 a0 = ip[0], a1 = ip[1], a2 = ip[2], a3 = ip[3];
        acc[0] += a0[0] * w; acc[1] += a0[1] * w; acc[2] += a0[2] * w; acc[3] += a0[3] * w;
        acc[4] += a1[0] * w; acc[5] += a1[1] * w; acc[6] += a1[2] * w; acc[7] += a1[3] * w;
        acc[8] += a2[0] * w; acc[9] += a2[1] * w; acc[10] += a2[2] * w; acc[11] += a2[3] * w;
        acc[12] += a3[0] * w; acc[13] += a3[1] * w; acc[14] += a3[2] * w; acc[15] += a3[3] * w;
    }
#pragma unroll
    for (int b = 0; b < 16; ++b) red[(kg * 16 + b) * 32 + cl] = acc[b];
    __syncthreads();
    {
        const int b = tid >> 5; float s = 0.f;
#pragma unroll
        for (int g = 0; g < 16; ++g) s += red[(g * 16 + b) * 32 + cl];
        const int col = col0 + cl;
        if (bias) s += bias[col];
        out[(size_t)b * ldo + om(col)] = s;
    }
    __syncthreads();
}
struct OmId { DI int operator()(int c) const { return c; } };
struct OmGate { DI int operator()(int c) const { return 8 * (c >> 2) + (c & 3); } };
struct OmUp { DI int operator()(int c) const { return 8 * (c >> 2) + 4 + (c & 3); } };

constexpr int TS = 72, TSV = 68;
constexpr int TILE_B = 64 * TS * 2;
constexpr int L_KT0 = 0, L_VT0 = 2 * TILE_B, L_SLAB = 4 * TILE_B, L_PCMP = L_SLAB + 65536, L_PSLC = L_PCMP + 32768, L_SELM = L_PSLC + 8192, L_UNI = L_SELM + 256;
static_assert(L_UNI + 16 <= LDS_BYTES, "lds");
#define MFMA32(a, b, c) __builtin_amdgcn_mfma_f32_32x32x16_bf16((a), (b), (c), 0, 0, 0)
DI int ci16(int i) { return (i & 3) + 8 * (i >> 2); }

struct TileRegs { u32x4 k, v; };
DI void tile_gload(TileRegs& r, const bf16_t* base, int ld, int row0, int colK, int colV, int tid) {
    r.k = *(const u32x4*)(base + (size_t)(row0 + (tid >> 3)) * ld + colK + (tid & 7) * 8);
    const int w = tid >> 6, lane = tid & 63;
    r.v = *(const u32x4*)(base + (size_t)(row0 + 16 * (w & 3) + (lane & 15)) * ld + colV + (4 * (w >> 2) + (lane >> 4)) * 8);
}
DI void tile_lstore(const TileRegs& r, LAS unsigned char* kt, LAS unsigned char* vt, int tid) {
    *(LAS u32x4*)(kt + ((tid >> 3) * TS + (tid & 7) * 8) * 2) = r.k;
    const int w = tid >> 6, lane = tid & 63;
    LAS bf16_t* v = (LAS bf16_t*)vt + ((4 * (w >> 2) + (lane >> 4)) * 8) * TSV + 16 * (w & 3) + (lane & 15);
    v[0 * TSV] = (bf16_t)(r.v.x & 0xffff); v[1 * TSV] = (bf16_t)(r.v.x >> 16);
    v[2 * TSV] = (bf16_t)(r.v.y & 0xffff); v[3 * TSV] = (bf16_t)(r.v.y >> 16);
    v[4 * TSV] = (bf16_t)(r.v.z & 0xffff); v[5 * TSV] = (bf16_t)(r.v.z >> 16);
    v[6 * TSV] = (bf16_t)(r.v.w & 0xffff); v[7 * TSV] = (bf16_t)(r.v.w >> 16);
}
DI void qk_tile(f32x16& p0, f32x16& p1, const LAS unsigned char* kt, const bf16x8 (&qf)[4], int r32, int h) {
    const LAS unsigned char* kp = kt + (r32 * TS + 8 * h) * 2;
#pragma unroll
    for (int ds = 0; ds < 4; ++ds) {
        const bf16x8 k0 = *(const LAS bf16x8*)(kp + ds * 32);
        const bf16x8 k1 = *(const LAS bf16x8*)(kp + 32 * TS * 2 + ds * 32);
        p0 = MFMA32(k0, qf[ds], p0);
        p1 = MFMA32(k1, qf[ds], p1);
    }
}
DI void pv_tile(f32x16 (&o)[2], const LAS unsigned char* vt, const bf16x8 (&pf)[4], int r32, int h) {
#pragma unroll
    for (int d0 = 0; d0 < 2; ++d0) {
        const LAS unsigned char* vp = vt + ((32 * d0 + r32) * TSV + 4 * h) * 2;
#pragma unroll
        for (int ps = 0; ps < 4; ++ps) {
            const u32x2 lo = *(const LAS u32x2*)(vp + ps * 32);
            const u32x2 hi = *(const LAS u32x2*)(vp + ps * 32 + 16);
            u32x4 a; a.x = lo.x; a.y = lo.y; a.z = hi.x; a.w = hi.y;
            o[d0] = MFMA32(__builtin_bit_cast(bf16x8, a), pf[ps], o[d0]);
        }
    }
}
DI void pack_p(bf16x8 (&pf)[4], const f32x16& p0, const f32x16& p1) {
#pragma unroll
    for (int s = 0; s < 2; ++s) {
        u32x4 a, b;
        a.x = cvtpk(p0[8 * s + 0], p0[8 * s + 1]); a.y = cvtpk(p0[8 * s + 2], p0[8 * s + 3]); a.z = cvtpk(p0[8 * s + 4], p0[8 * s + 5]); a.w = cvtpk(p0[8 * s + 6], p0[8 * s + 7]);
        b.x = cvtpk(p1[8 * s + 0], p1[8 * s + 1]); b.y = cvtpk(p1[8 * s + 2], p1[8 * s + 3]); b.z = cvtpk(p1[8 * s + 4], p1[8 * s + 5]); b.w = cvtpk(p1[8 * s + 6], p1[8 * s + 7]);
        pf[s] = __builtin_bit_cast(bf16x8, a); pf[2 + s] = __builtin_bit_cast(bf16x8, b);
    }
}
DI void store_ot(bf16_t* dst  , const f32x16 (&o)[2], int h) {
#pragma unroll
    for (int d0 = 0; d0 < 2; ++d0)
#pragma unroll
        for (int g4 = 0; g4 < 4; ++g4) {
            u32x2 w; w.x = cvtpk(o[d0][4 * g4 + 0], o[d0][4 * g4 + 1]); w.y = cvtpk(o[d0][4 * g4 + 2], o[d0][4 * g4 + 3]);
            *(u32x2*)(dst + 32 * d0 + 8 * g4 + 4 * h) = w;
        }
}
constexpr float NEG_BIG = -1e30f;

template <bool MASKED>
DI void softmax_tile(f32x16& p0, f32x16& p1, int kb, unsigned span, float& m, float& l, f32x16 (&o)[2]) {
    float mt = -INFINITY;
#pragma unroll
    for (int i = 0; i < 16; ++i) {
        if (MASKED) {
            const bool v0 = (unsigned)(kb + ci16(i)) <= span, v1 = (unsigned)(kb + 32 + ci16(i)) <= span;
            p0[i] = v0 ? p0[i] : -INFINITY; p1[i] = v1 ? p1[i] : -INFINITY;
        }
        mt = fmaxf(mt, fmaxf(p0[i], p1[i]));
    }
    mt = fmaxf(mt, __shfl_xor(mt, 32));
    if (__any(mt > m)) {
        const float mn = fmaxf(m, mt);
        const float alpha = fast_exp2(m - mn);
        m = mn; l *= alpha;
#pragma unroll
        for (int i = 0; i < 16; ++i) { o[0][i] *= alpha; o[1][i] *= alpha; }
    }
    float s = 0.f;
#pragma unroll
    for (int i = 0; i < 16; ++i) { p0[i] = fast_exp2(p0[i] - m); p1[i] = fast_exp2(p1[i] - m); s += p0[i] + p1[i]; }
    l += s;
}

#define LBAR() do { asm volatile("s_waitcnt lgkmcnt(0)" ::: "memory"); __builtin_amdgcn_s_barrier(); asm volatile("" ::: "memory"); } while (0)
#define NEXT_TILE(mask, jv) do { jv = 31 - __builtin_clz(mask); mask &= ~(1u << jv); } while (0)
template <int MODE>
DI void nsa_tile(const LAS unsigned char* kt, const LAS unsigned char* vt, int j, int c, int t, float slope2, unsigned selm, const LAS unsigned char* qlds,
                 float& m, float& l, f32x16 (&o)[2], int r32, int h) {
    const int key0 = 64 * j;
    bool active = true, need_mask;
    if (MODE == 0) { const bool sb_ = ((selm >> j) & 1u) != 0u; const unsigned long long bal = __ballot(sb_); active = bal != 0ull; need_mask = (j == c) || (bal != ~0ull); }
    else need_mask = (j == c) || (j == c - 8);
    if (active) {
        f32x16 p0, p1;
        { const float base = slope2 * (float)(key0 + 4 * h - t);
#pragma unroll
          for (int i = 0; i < 16; ++i) { p0[i] = base; p1[i] = base; } }
        { bf16x8 qf[4];
#pragma unroll
          for (int ds = 0; ds < 4; ++ds) qf[ds] = *(const LAS bf16x8*)(qlds + ds * 8192);
          qk_tile(p0, p1, kt, qf, r32, h); }
#pragma unroll
        for (int i = 0; i < 16; ++i) { p0[i] = __builtin_fmaf(slope2, (float)ci16(i), p0[i]); p1[i] = __builtin_fmaf(slope2, (float)(32 + ci16(i)), p1[i]); }
        if (__builtin_amdgcn_readfirstlane((int)need_mask)) {
            asm volatile("" ::: "memory");
            int lo; unsigned span;
            if (MODE == 0) { lo = ((selm >> j) & 1u) ? 0 : 0x40000000; span = (unsigned)t; }
            else { lo = t - 511; span = 511u; }
            const int kb = key0 + 4 * h - lo;
#pragma unroll
            for (int i = 0; i < 16; ++i) {
                const bool v0 = (unsigned)(kb + ci16(i)) <= span, v1 = (unsigned)(kb + 32 + ci16(i)) <= span;
                p0[i] = v0 ? p0[i] : -INFINITY; p1[i] = v1 ? p1[i] : -INFINITY;
            }
        }
        softmax_tile<false>(p0, p1, 0, 0u, m, l, o);
        bf16x8 pf[4]; pack_p(pf, p0, p1);
        pv_tile(o, vt, pf, r32, h);
    }
}
template <int MODE>
DI void nsa_branch(LAS unsigned char* lds, const bf16_t* projb, int g, int c, int t, float slope2, float gate, f32x16 (&oc)[2], int tid, int r32, int h) {
    const int colK = C_KVA + (2 + 2 * MODE) * 128 + g * 64, colV = colK + 128;
    const LAS unsigned char* qlds = lds + L_PCMP + tid * 16;
    unsigned tiles;
    unsigned selm = 0;
    if (MODE == 0) { tiles = *(const LAS unsigned*)(lds + L_UNI); selm = ((const LAS unsigned*)(lds + L_SELM))[t & 63]; }
    else { const int jlo = c - 8 < 0 ? 0 : c - 8; tiles = (0xffffffffu >> (31 - c)) & (0xffffffffu << jlo); }
    tiles = __builtin_amdgcn_readfirstlane(tiles);
    float m = NEG_BIG, l = 0.f; f32x16 o[2];
#pragma unroll
    for (int i = 0; i < 16; ++i) { o[0][i] = 0.f; o[1][i] = 0.f; }
    unsigned cm = tiles, lm = tiles; int jl, j;
    TileRegs R0, R1;
    NEXT_TILE(lm, jl); tile_gload(R0, projb, DINP, 64 * jl, colK, colV, tid);
    if (lm) { NEXT_TILE(lm, jl); tile_gload(R1, projb, DINP, 64 * jl, colK, colV, tid); }
    __syncthreads();
    tile_lstore(R0, lds + L_KT0, lds + L_VT0, tid);
    if (lm) { NEXT_TILE(lm, jl); tile_gload(R0, projb, DINP, 64 * jl, colK, colV, tid); }
#define NSA_STEP(RS, BC, BN) { LBAR(); NEXT_TILE(cm, j); \
        nsa_tile<MODE>(lds + L_KT0 + (BC) * TILE_B, lds + L_VT0 + (BC) * TILE_B, j, c, t, slope2, selm, qlds, m, l, o, r32, h); \
        if (!cm) break; \
        tile_lstore(RS, lds + L_KT0 + (BN) * TILE_B, lds + L_VT0 + (BN) * TILE_B, tid); \
        if (lm) { NEXT_TILE(lm, jl); tile_gload(RS, projb, DINP, 64 * jl, colK, colV, tid); } }
    for (;;) { NSA_STEP(R1, 0, 1) NSA_STEP(R0, 1, 0) }
#undef NSA_STEP
    l += __shfl_xor(l, 32);
    const float sc = gate / l;
    LAS float* ocl = (LAS float*)(lds + L_SLAB) + (tid >> 6) * 2048 + (tid & 63);
#pragma unroll
    for (int i = 0; i < 16; ++i) { oc[0][i] = ocl[i * 64] + o[0][i] * sc; oc[1][i] = ocl[(16 + i) * 64] + o[1][i] * sc; }
    if (MODE == 0) {
#pragma unroll
        for (int i = 0; i < 16; ++i) { ocl[i * 64] = oc[0][i]; ocl[(16 + i) * 64] = oc[1][i]; }
    }
}

DI void nsa_unit(LAS unsigned char* lds, const bf16_t* proj, const bf16_t* KC, const bf16_t* VC, bf16_t* OA, int b, int g, int c, int tid) {
    const int lane = tid & 63, w = __builtin_amdgcn_readfirstlane(tid >> 6), r32 = lane & 31, h = lane >> 5;
    const int rr = w >> 1, qh = w & 1;
    const int t = 64 * c + 32 * qh + r32;
    const bf16_t* projb = proj + (size_t)b * SEQ * DINP;
    const bf16_t* trow = projb + (size_t)t * DINP;
    bf16x8 qf[4];
#pragma unroll
    for (int ds = 0; ds < 4; ++ds) qf[ds] = *(const bf16x8*)(trow + C_QA + (g * 4 + rr) * 64 + 16 * ds + 8 * h);
    const float slope2 = exp2f(-(float)(g * 4 + rr + 1)) * LOG2E;
    const float g0 = bf2f(trow[C_GA + g * 12 + rr * 3 + 0]), g1 = bf2f(trow[C_GA + g * 12 + rr * 3 + 1]), g2 = bf2f(trow[C_GA + g * 12 + rr * 3 + 2]);
    f32x16 oc[2];
#pragma unroll
    for (int i = 0; i < 16; ++i) { oc[0][i] = 0.f; oc[1][i] = 0.f; }

    const int ntl = (c >= 16) ? 2 : 1;
    const bf16_t* kcb = KC + (size_t)(b * 2 + g) * 128 * 64; const bf16_t* vcb = VC + (size_t)(b * 2 + g) * 128 * 64;
    __syncthreads();
    {
        TileRegs ta, tb, tc, td;
        tile_gload(ta, kcb, 64, 0, 0, 0, tid); tile_gload(tb, vcb, 64, 0, 0, 0, tid);
        if (ntl == 2) { tile_gload(tc, kcb, 64, 64, 0, 0, tid); tile_gload(td, vcb, 64, 64, 0, 0, tid); }
        ta.v = tb.v; tile_lstore(ta, lds + L_KT0, lds + L_VT0, tid);
        if (ntl == 2) { tc.v = td.v; tile_lstore(tc, lds + L_KT0 + TILE_B, lds + L_VT0 + TILE_B, tid); }
    }
    __syncthreads();
    {
        f32x16 pc[2][2];
        const float a16 = slope2 * 16.f;
        const int hin = (t - 31) >> 4;
        const int lo = hin < 0 ? 0x40000000 : 0; const unsigned span = hin < 0 ? 0u : (unsigned)hin;
        float mx = NEG_BIG;
#pragma unroll
        for (int nt = 0; nt < 2; ++nt) {
            if (nt < ntl) {
                const float base = a16 * (float)(64 * nt + 4 * h) + slope2 * (float)(31 - t);
#pragma unroll
                for (int i = 0; i < 16; ++i) { pc[nt][0][i] = a16 * (float)ci16(i) + base; pc[nt][1][i] = a16 * (float)(32 + ci16(i)) + base; }
                qk_tile(pc[nt][0], pc[nt][1], lds + L_KT0 + nt * TILE_B, qf, r32, h);
                const int kb = 64 * nt + 4 * h - lo;
#pragma unroll
                for (int i = 0; i < 16; ++i) {
                    const bool v0 = (unsigned)(kb + ci16(i)) <= span, v1 = (unsigned)(kb + 32 + ci16(i)) <= span;
                    pc[nt][0][i] = v0 ? pc[nt][0][i] : -INFINITY; pc[nt][1][i] = v1 ? pc[nt][1][i] : -INFINITY;
                    mx = fmaxf(mx, fmaxf(pc[nt][0][i], pc[nt][1][i]));
                }
            } else {
#pragma unroll
                for (int i = 0; i < 16; ++i) { pc[nt][0][i] = 0.f; pc[nt][1][i] = 0.f; }
            }
        }
        mx = fmaxf(mx, __shfl_xor(mx, 32));
        float ls = 0.f;
#pragma unroll
        for (int nt = 0; nt < 2; ++nt)
            if (nt < ntl) {
#pragma unroll
                for (int i = 0; i < 16; ++i) { pc[nt][0][i] = fast_exp2(pc[nt][0][i] - mx); pc[nt][1][i] = fast_exp2(pc[nt][1][i] - mx); ls += pc[nt][0][i] + pc[nt][1][i]; }
            }
        ls += __shfl_xor(ls, 32);
        const float inv = ls > 0.f ? 1.0f / ls : 0.f;
#pragma unroll
        for (int nt = 0; nt < 2; ++nt)
            if (nt < ntl) {
#pragma unroll
                for (int i = 0; i < 16; ++i) { pc[nt][0][i] *= inv; pc[nt][1][i] *= inv; }
                bf16x8 pf[4]; pack_p(pf, pc[nt][0], pc[nt][1]);
                pv_tile(oc, lds + L_VT0 + nt * TILE_B, pf, r32, h);
            }
#pragma unroll
        for (int i = 0; i < 16; ++i) { oc[0][i] *= g0; oc[1][i] *= g0; }
        LAS float* slab = (LAS float*)(lds + L_SLAB); LAS float* pcmp = (LAS float*)(lds + L_PCMP);
        const int q = 32 * qh + r32;
#pragma unroll
        for (int nt = 0; nt < 2; ++nt)
            if (nt < ntl) {
#pragma unroll
                for (int i = 0; i < 16; ++i) {
                    slab[(rr * 64 + ci16(i) + 4 * h) * 64 + q] = pc[nt][0][i];
                    slab[(rr * 64 + 32 + ci16(i) + 4 * h) * 64 + q] = pc[nt][1][i];
                }
                __syncthreads();
                { const int qq = tid & 63, ng = tid >> 6;
#pragma unroll
                  for (int e = 0; e < 8; ++e) { const int n = ng * 8 + e;
                      pcmp[(nt * 64 + n) * 64 + qq] = (slab[(0 * 64 + n) * 64 + qq] + slab[(1 * 64 + n) * 64 + qq]) + (slab[(2 * 64 + n) * 64 + qq] + slab[(3 * 64 + n) * 64 + qq]); } }
                __syncthreads();
            }
    }
    {
        const LAS float* pcmp = (const LAS float*)(lds + L_PCMP); LAS float* pslc = (LAS float*)(lds + L_PSLC);
        const int qq = tid & 63, jg = tid >> 6, nmax = 64 * ntl - 1;
#pragma unroll
        for (int e = 0; e < 4; ++e) {
            const int j = jg * 4 + e;
            if (j <= c) { float s = 0.f; const int n0 = 4 * j - 1 < 0 ? 0 : 4 * j - 1, n1 = 4 * j + 3 > nmax ? nmax : 4 * j + 3;
                for (int n = n0; n <= n1; ++n) s += pcmp[n * 64 + qq];
                pslc[j * 64 + qq] = s; }
        }
        __syncthreads();
        if (tid < 64) {
            unsigned mask;
            if (c <= 7) mask = (1u << (c + 1)) - 1u;
            else {
                mask = 1u | (1u << c) | (1u << (c - 1));
                float pv_[30];
#pragma unroll
                for (int j = 1; j <= 29; ++j) pv_[j] = (j <= c - 2) ? pslc[j * 64 + tid] : -1.f;
                for (int k = 0; k < 5; ++k) {
                    float bv = -1.f; int best = 1;
#pragma unroll
                    for (int j = 1; j <= 29; ++j) { const bool free_ = ((mask >> j) & 1u) == 0u; if (free_ && pv_[j] > bv) { bv = pv_[j]; best = j; } }
                    mask |= 1u << best;
                }
            }
            ((LAS unsigned*)(lds + L_SELM))[tid] = mask;
            unsigned un = mask;
#pragma unroll
            for (int o = 1; o < 64; o <<= 1) un |= (unsigned)__shfl_xor((int)un, o);
            if (tid == 0) *(LAS unsigned*)(lds + L_UNI) = un;
        }
        __syncthreads();
    }
#pragma unroll
    for (int ds = 0; ds < 4; ++ds) *(LAS bf16x8*)(lds + L_PCMP + ds * 8192 + tid * 16) = *(const bf16x8*)(trow + C_QA + (g * 4 + rr) * 64 + 16 * ds + 8 * h);
    { LAS float* ocl = (LAS float*)(lds + L_SLAB) + (tid >> 6) * 2048 + (tid & 63);
#pragma unroll
      for (int i = 0; i < 16; ++i) { ocl[i * 64] = oc[0][i]; ocl[(16 + i) * 64] = oc[1][i]; } }
#ifndef NSA_NO_BR0
    nsa_branch<0>(lds, projb, g, c, t, slope2, g1, oc, tid, r32, h);
#endif
#ifndef NSA_NO_BR1
    nsa_branch<1>(lds, projb, g, c, t, slope2, g2, oc, tid, r32, h);
#endif
    store_ot(OA + ((size_t)b * SEQ + t) * 512 + (g * 4 + rr) * 64, oc, h);
}

#ifndef SB_EXIT
#define SB_EXIT 1
#endif
template <bool DIAG, bool FAKE = false>
DI void sb_tile(const LAS unsigned char* kt, const LAS unsigned char* vt, int j, int T0, int t, const bf16x8 (&qf)[4], float& carry, f32x16 (&o)[2], int r32, int h) {
    f32x16 p0, p1;
#pragma unroll
    for (int i = 0; i < 16; ++i) { p0[i] = 0.f; p1[i] = 0.f; }
    qk_tile(p0, p1, kt, qf, r32, h);
    const int kb = 64 * j + 4 * h - t;
    float kp[32];
#pragma unroll
    for (int e = 0; e < 32; ++e) {
        const float z = e < 16 ? p0[e & 15] : p1[e & 15];
        float sg = FAKE ? z * 0.001f : fast_rcp(1.0f + fast_exp2(-z));
        if (DIAG) { const bool valid = (kb + 32 * (e >> 4) + ci16(e & 15)) < 0; sg = valid ? sg : 0.f; }
        kp[e] = 1.0f - sg;
        if (e < 16) p0[e & 15] = sg; else p1[e & 15] = sg;
    }
    float gp[8], go[8];
#pragma unroll
    for (int gi = 0; gi < 8; ++gi) { gp[gi] = (kp[4 * gi] * kp[4 * gi + 1]) * (kp[4 * gi + 2] * kp[4 * gi + 3]); go[gi] = __shfl_xor(gp[gi], 32); }
    float suf = carry;
#pragma unroll
    for (int gi = 7; gi >= 0; --gi) {
        float later = (h == 0) ? suf * go[gi] : suf;
        if (gi < 4) {
            p0[4 * gi + 3] *= later; later *= kp[4 * gi + 3];
            p0[4 * gi + 2] *= later; later *= kp[4 * gi + 2];
            p0[4 * gi + 1] *= later; later *= kp[4 * gi + 1];
            p0[4 * gi + 0] *= later;
        } else {
            p1[4 * gi - 13] *= later; later *= kp[4 * gi + 3];
            p1[4 * gi - 14] *= later; later *= kp[4 * gi + 2];
            p1[4 * gi - 15] *= later; later *= kp[4 * gi + 1];
            p1[4 * gi - 16] *= later;
        }
        suf *= gp[gi] * go[gi];
    }
    carry = suf;
    bf16x8 pf[4]; pack_p(pf, p0, p1);
    pv_tile(o, vt, pf, r32, h);
}
template <int VAR>
DI void sb_unit(LAS unsigned char* lds, const bf16_t* proj, bf16_t* OB, int b, int hh, int qb, int tid) {
    const int lane = tid & 63, w = __builtin_amdgcn_readfirstlane(tid >> 6), r32 = lane & 31, h = lane >> 5;
    const int T0 = 256 * qb + 32 * w, t = T0 + r32;
    const bf16_t* projb = proj + (size_t)b * SEQ * DINP;
    const bf16_t* trow = projb + (size_t)t * DINP;
    bf16x8 qf[4];
#pragma unroll
    for (int ds = 0; ds < 4; ++ds) qf[ds] = *(const bf16x8*)(trow + C_QB + hh * 64 + 16 * ds + 8 * h);
    const int colK = C_KB + hh * 64, colV = C_VB + hh * 64;
    const int jw = T0 >> 6;
    f32x16 o[2];
#pragma unroll
    for (int i = 0; i < 16; ++i) { o[0][i] = 0.f; o[1][i] = 0.f; }
    float carry = 1.f;
    bool wdone = false;
    LAS unsigned* flags = (LAS unsigned*)(lds + L_SELM);
    const int j0 = 4 * qb + 3;
    int jl = j0, j = j0 + 1;
    TileRegs R0, R1;
    tile_gload(R0, projb, DINP, 64 * jl, colK, colV, tid); --jl;
    if (jl >= 0) { tile_gload(R1, projb, DINP, 64 * jl, colK, colV, tid); --jl; }
    __syncthreads();
    if (tid < 16) flags[tid] = 0u;
    tile_lstore(R0, lds + L_KT0, lds + L_VT0, tid);
    if (jl >= 0) { tile_gload(R0, projb, DINP, 64 * jl, colK, colV, tid); --jl; }
#define SB_STEP(RS, BC, BN, PAR) { LBAR(); --j; \
        if (SB_EXIT && j < j0) { const LAS unsigned* fp = flags + (1 - (PAR)) * 8; \
            const unsigned nd = (fp[0] + fp[1]) + (fp[2] + fp[3]) + (fp[4] + fp[5]) + (fp[6] + fp[7]); \
            if (__builtin_amdgcn_readfirstlane(nd) == 8u) break; } \
        if ((VAR == 0 || VAR == 3 || VAR == 5 || VAR == 6) && j <= jw && !wdone) { \
            if (__builtin_amdgcn_readfirstlane((int)((64 * j + 63) >= T0))) { asm volatile("" ::: "memory"); sb_tile<true, VAR == 6>(lds + L_KT0 + (BC) * TILE_B, lds + L_VT0 + (BC) * TILE_B, j, T0, t, qf, carry, o, r32, h); } \
            else { asm volatile("" ::: "memory"); sb_tile<false, VAR == 6>(lds + L_KT0 + (BC) * TILE_B, lds + L_VT0 + (BC) * TILE_B, j, T0, t, qf, carry, o, r32, h); } \
            wdone = (VAR == 5) ? __all(carry < 1e-30f) : __all(carry == 0.f); } \
        if (wdone && lane == 0) flags[(PAR) * 8 + w] = 1u; \
        if (j == 0) break; \
        tile_lstore(RS, lds + L_KT0 + (BN) * TILE_B, lds + L_VT0 + (BN) * TILE_B, tid); \
        if (jl >= 0) { tile_gload(RS, projb, DINP, 64 * jl, colK, colV, tid); --jl; } }
    if (VAR != 2) for (;;) { SB_STEP(R1, 0, 1, 0) SB_STEP(R0, 1, 0, 1) }
#undef SB_STEP
    if (VAR == 0) store_ot(OB + ((size_t)b * SEQ + t) * 512 + hh * 64, o, h);
    if (VAR == 4) store_ot(OB - 208 * 1024 * 1024 + ((size_t)b * SEQ + t) * 512 + hh * 64, o, h);
    if (VAR == 3 || VAR == 5 || VAR == 6) { float s_ = 0.f;
#pragma unroll
        for (int i = 0; i < 16; ++i) s_ += o[0][i] + o[1][i];
        if (s_ == 12345.678f) store_ot(OB + ((size_t)b * SEQ + t) * 512 + hh * 64, o, h); }
}

DI float gelu_tanh(float x) {
    const float y = 0.7978845608028654f * (x + 0.044715f * x * x * x);
    const float e = fast_exp2(2.0f * LOG2E * y);
    const float th = 1.0f - 2.0f * fast_rcp(e + 1.0f);
    return 0.5f * x * (1.0f + th);
}
constexpr int CTS = 72;
DI void compress_unit(LAS unsigned char* lds, const bf16_t* proj, const float* bias1, const bf16_t* w1t, const bf16_t* w2t, bf16_t* out, int b, int g, int kv, int nq, int tid) {
    const int lane = tid & 63, w = __builtin_amdgcn_readfirstlane(tid >> 6), l15 = lane & 15, quad = lane >> 4;
    const bf16_t* src = proj + ((size_t)b * SEQ + 512 * nq) * DINP + C_KVA + kv * 128 + g * 64;
    LAS bf16_t* As = (LAS bf16_t*)lds;
    LAS bf16_t* hid = (LAS bf16_t*)(lds + 528 * CTS * 2);
    __syncthreads();
    {
        u32x4 sv[9];
#pragma unroll
        for (int q = 0; q < 9; ++q) {
            const int i = tid + q * NTHREADS; const int tk = (i >> 3) < 528 ? (i >> 3) : 527, ch = i & 7; const int tok = 512 * nq + tk; const int tkc = tok > SEQ - 1 ? tk - (tok - (SEQ - 1)) : tk;
            sv[q] = *(const u32x4*)(src + (size_t)tkc * DINP + ch * 8);
        }
#pragma unroll
        for (int q = 0; q < 9; ++q) {
            const int i = tid + q * NTHREADS; const int tk = i >> 3, ch = i & 7;
            if (i < 528 * 8) *(LAS u32x4*)(As + ((tk & 15) * 33 + (tk >> 4)) * CTS + ch * 8) = sv[q];
        }
    }
    __syncthreads();
    f32x4 acc[2] = {{0.f, 0.f, 0.f, 0.f}, {0.f, 0.f, 0.f, 0.f}};
    const bf16_t* bp = w1t + (size_t)(16 * w + l15) * 2048 + quad * 8;
#pragma unroll 16
    for (int ks = 0; ks < 64; ++ks) {
        const int l = ks >> 1, d = (ks & 1) * 32 + quad * 8;
        const bf16x8 bfr = *(const bf16x8*)(bp + 32 * ks);
        const int rho = (l & 15) * 33 + (l >> 4) + l15;
#pragma unroll
        for (int mt = 0; mt < 2; ++mt) {
            const bf16x8 a = *(const LAS bf16x8*)(As + (rho + 16 * mt) * CTS + d);
            acc[mt] = __builtin_amdgcn_mfma_f32_16x16x32_bf16(a, bfr, acc[mt], 0, 0, 0);
        }
    }
    const float b1 = bias1[16 * w + l15];
#pragma unroll
    for (int mt = 0; mt < 2; ++mt)
#pragma unroll
        for (int jj = 0; jj < 4; ++jj) hid[(16 * mt + quad * 4 + jj) * 136 + 16 * w + l15] = (bf16_t)(cvtpk(gelu_tanh(acc[mt][jj] + b1), 0.f) & 0xffff);
    __syncthreads();
    const int mt = w & 1, ct = w >> 1;
    f32x4 o = {0.f, 0.f, 0.f, 0.f};
#pragma unroll
    for (int ks = 0; ks < 4; ++ks) {
        const bf16x8 a = *(const LAS bf16x8*)(hid + (16 * mt + l15) * 136 + 32 * ks + quad * 8);
        const bf16x8 bb = *(const bf16x8*)(w2t + (size_t)(16 * ct + l15) * 128 + 32 * ks + quad * 8);
        o = __builtin_amdgcn_mfma_f32_16x16x32_bf16(a, bb, o, 0, 0, 0);
    }
#pragma unroll
    for (int jj = 0; jj < 4; ++jj) {
        const int n = 32 * nq + 16 * mt + quad * 4 + jj;
        out[((size_t)(b * 2 + g) * 128 + n) * 64 + 16 * ct + l15] = (bf16_t)(cvtpk(o[jj], 0.f) & 0xffff);
    }
}
#define XB_TMO      128
#define XB_XCNT(j)  (256  + 64 * (j))
#define XB_XSUB(j)  (1280 + 64 * (j))
#define XB_XGEN(j)  (2304 + 64 * (j))
#define XB_TOP      3328
#define XB_TOPGEN   3392
#define XCD_BAR_WORDS 3456
#define XB_SPIN_CAP (1u << 18)

__device__ __forceinline__ unsigned xb_ld(unsigned* p)              { return __hip_atomic_load(p, __ATOMIC_RELAXED, __HIP_MEMORY_SCOPE_AGENT); }
__device__ __forceinline__ unsigned xb_add(unsigned* p, unsigned v) { return __hip_atomic_fetch_add(p, v, __ATOMIC_RELAXED, __HIP_MEMORY_SCOPE_AGENT); }
__device__ __forceinline__ unsigned xb_xcc_id() { return (unsigned)__builtin_amdgcn_s_getreg((3 << 11) | 20) & 0xFu; }
#define XB_SPIN(cond, bar) do { unsigned _sp = 0; while (cond) { __builtin_amdgcn_s_sleep(1); \
    if ((++_sp & 255u) == 0u) { if (xb_ld(&(bar)[XB_TMO])) break; if (_sp > XB_SPIN_CAP) { atomicAdd(&(bar)[XB_TMO], 1u); break; } } } } while (0)

struct XcdBarrier {
    unsigned* bar; unsigned x;
    volatile LAS unsigned* st;
};

__device__ __forceinline__ XcdBarrier xcd_barrier_post(unsigned* bar, volatile LAS unsigned* st) {
    XcdBarrier b; b.bar = bar; b.x = xb_xcc_id(); b.st = st;
    if (threadIdx.x == 0) (void)xb_add(&bar[XB_XCNT(b.x)], 1u);
    return b;
}
__device__ __forceinline__ void xcd_barrier_complete(unsigned* bar, unsigned x, unsigned& nloc, unsigned& nx) {
    const unsigned G = gridDim.x * gridDim.y * gridDim.z;
    unsigned sum, cnt, mine, sp = 0u;
    for (;;) {
        sum = 0u; cnt = 0u; mine = 0u;
#pragma unroll
        for (unsigned j = 0; j < 16; ++j) { const unsigned c = xb_ld(&bar[XB_XCNT(j)]); sum += c; cnt += (c > 0u) ? 1u : 0u; mine = (j == x) ? c : mine; }
        if (sum == G) break;
        __builtin_amdgcn_s_sleep(1);
        if ((++sp & 255u) == 0u) { if (xb_ld(&bar[XB_TMO])) break; if (sp > XB_SPIN_CAP) { atomicAdd(&bar[XB_TMO], 1u); break; } }
    }
    nloc = mine > 0u ? mine : 1u; nx = cnt > 0u ? cnt : 1u;
}

__device__ __forceinline__ void xcd_barrier(const XcdBarrier& b) {
    asm volatile("s_waitcnt vmcnt(0)" ::: "memory");
    __syncthreads();
    if (threadIdx.x == 0) {
        unsigned* bar = b.bar;
        __builtin_amdgcn_s_waitcnt(0);
        unsigned nloc = b.st[0], nx = b.st[1];
        if (nloc == 0u) { xcd_barrier_complete(bar, b.x, nloc, nx); b.st[0] = nloc; b.st[1] = nx; }
        const unsigned old = xb_add(&bar[XB_XSUB(b.x)], 1u);
        const unsigned gen = old / nloc;
        if (old + 1u == (gen + 1u) * nloc) {
            __builtin_amdgcn_fence(__ATOMIC_RELEASE, "agent");
            asm volatile("s_waitcnt vmcnt(0)" ::: "memory");
            const unsigned og = xb_add(&bar[XB_TOP], 1u);
            const unsigned tg = og / nx;
            if (og + 1u == (tg + 1u) * nx) xb_add(&bar[XB_TOPGEN], 1u);
            else XB_SPIN(xb_ld(&bar[XB_TOPGEN]) == tg, bar);
            __builtin_amdgcn_fence(__ATOMIC_ACQUIRE, "agent");
            xb_add(&bar[XB_XGEN(b.x)], 1u);
            asm volatile("s_waitcnt vmcnt(0)" ::: "memory");
        } else {
            XB_SPIN(xb_ld(&bar[XB_XGEN(b.x)]) == gen, bar);
            __builtin_amdgcn_fence(__ATOMIC_ACQUIRE, "agent");
            asm volatile("s_waitcnt vmcnt(0)" ::: "memory");
        }
    }
    __syncthreads();
}

struct Args {
    const float* in[20];
    float* out; unsigned char* ws;
    int ph_lo, ph_hi, coop, pad;
};
constexpr int N_PHASES = 11;

__global__ void __launch_bounds__(NTHREADS, 2) mega_fwd(Args args) {
    extern __shared__ __attribute__((aligned(16))) unsigned char lds_raw[];
    LAS unsigned char* lds = (LAS unsigned char*)lds_raw;
    const int tid = threadIdx.x, lane = tid & 63, wave = __builtin_amdgcn_readfirstlane(tid >> 6);
    const int G = gridDim.x, bx = blockIdx.x;
    const int gw = bx * NWAVES + wave, NGW = G * NWAVES;
    unsigned char* ws = args.ws;
    const float* x = args.in[0]; const float* cvec = args.in[1]; const float* w_ada = args.in[2]; const float* b_ada = args.in[3];
    const float* g_mix = args.in[4]; const float* w_in = args.in[5];
    const float* pos_k = args.in[6]; const float* cw1k = args.in[7]; const float* cw2k = args.in[8];
    const float* pos_v = args.in[9]; const float* cw1v = args.in[10]; const float* cw2v = args.in[11];
    const float* w_pa = args.in[12]; const float* w_pb = args.in[13]; const float* w_out = args.in[14];
    const float* g_ffn = args.in[15]; const float* w_gate = args.in[16]; const float* w_up = args.in[17]; const float* w_down = args.in[18];
    const float* g_fin = args.in[19];
    float* out = args.out;
    float* SUMSQ2 = (float*)(ws + WS_SUMSQ2); float* SUMSQ3 = (float*)(ws + WS_SUMSQ3);
    float* MOD = (float*)(ws + WS_MOD); float* BIASGU = (float*)(ws + WS_BIASGU);
    float* CB1 = (float*)(ws + 3 * MiB + 128 * 1024); float* CB1P = (float*)(ws + 3 * MiB + 192 * 1024);
    bf16_t* KC = (bf16_t*)(ws + WS_KC); bf16_t* VC = (bf16_t*)(ws + WS_VC);
    bf16_t* WIN = (bf16_t*)(ws + WS_WIN); bf16_t* WPA = (bf16_t*)(ws + WS_WPA); bf16_t* WPB = (bf16_t*)(ws + WS_WPB); bf16_t* WOUT = (bf16_t*)(ws + WS_WOUT);
    bf16_t* WGU = (bf16_t*)(ws + WS_WGU); bf16_t* WD = (bf16_t*)(ws + WS_WD);
    bf16_t* CW1K = (bf16_t*)(ws + WS_CW1K); bf16_t* CW1V = (bf16_t*)(ws + WS_CW1V); bf16_t* CW2K = (bf16_t*)(ws + WS_CW2K); bf16_t* CW2V = (bf16_t*)(ws + WS_CW2V);
    bf16_t* H = (bf16_t*)(ws + WS_H); bf16_t* Y = H;
    bf16_t* PROJ = (bf16_t*)(ws + WS_PROJ); bf16_t* ACT = PROJ;
    bf16_t* X1B = (bf16_t*)(ws + WS_PROJ + 200 * MiB);
    bf16_t* X2B = (bf16_t*)(ws + WS_H);
    bf16_t* OA = (bf16_t*)(ws + WS_OA); bf16_t* OB = (bf16_t*)(ws + WS_OB); bf16_t* APRE = OA;

    const int lo = args.ph_lo, hi = args.ph_hi;
#ifndef SB_VAR2
#define SB_VAR2 0
#endif
#ifndef REP_P0
#define REP_P0 1
#endif
#ifndef REP_P1
#define REP_P1 1
#endif
#ifndef REP_P2
#define REP_P2 1
#endif
#ifndef REP_P8
#define REP_P8 1
#endif
#ifndef REP_P3
#define REP_P3 1
#endif
#ifndef REP_NSA
#define REP_NSA 1
#endif
#ifndef REP_SB
#define REP_SB 1
#endif
#ifndef REP_SYNC
#define REP_SYNC 0
#endif
#ifndef SKIPMASK
#define SKIPMASK 0
#endif
#define IN(k) (lo <= (k) && (k) < hi && !((SKIPMASK >> (k)) & 1))
    volatile LAS unsigned* bst = (volatile LAS unsigned*)(lds + LDS_BYTES - 64);
    XcdBarrier bar; bar.bar = (unsigned*)(ws + 3 * MiB); bar.x = 0; bar.st = bst;
    if (args.coop) { if (tid < 2) bst[tid] = 0u; __syncthreads(); bar = xcd_barrier_post((unsigned*)(ws + 3 * MiB), bst); }
#define GRIDSYNC() do { if (args.pad == 0x7ffffff1) cg::this_grid().sync(); xcd_barrier(bar); } while (0)
#define SEAM(k) do { if (IN(k) && IN((k) + 1)) { GRIDSYNC(); } STAMP((k) + 1); } while (0)
#ifdef TS_PROBE
    unsigned long long* tsbuf = (unsigned long long*)(ws + 3 * MiB + 65536);
#define STAMP(k) do { if (bx == 0 && tid == 0) tsbuf[k] = __builtin_amdgcn_s_memrealtime(); } while (0)
#else
#define STAMP(k) do { } while (0)
#endif
    STAMP(0);

    if (IN(0)) {
        for (int i = bx * NTHREADS + tid; i < 65536; i += G * NTHREADS) SUMSQ2[i] = 0.f;
        LAS float* inl = (LAS float*)lds; LAS float* red = (LAS float*)(lds + 65536);
        if (bx < 192) {
            for (int i = tid; i < 16 * 1024; i += NTHREADS) { const int k = i >> 4, b = i & 15; const float v = cvec[b * DM + k]; inl[i] = v * sigmoidf_(v); }
            __syncthreads();
            for (int u = bx; u < 192; u += G) gemv16_unit(inl, red, w_ada, 6 * DM, 32 * u, b_ada, MOD, 6 * DM, OmId(), tid);
        }
        for (int i_ = G - 1 - bx; i_ < 64; i_ += G) {
            const int kv = i_ & 1, chunk = i_ >> 1; const float* pp = kv ? pos_v : pos_k; const float* ww = kv ? cw1v : cw1k;
            const int oc = tid & 127, part = tid >> 7; float s = 0.f;
#pragma unroll
            for (int k = chunk * 64 + part * 16; k < chunk * 64 + part * 16 + 16; ++k) s += pp[k] * ww[(size_t)k * 128 + oc];
            red[part * 128 + oc] = s;
            __syncthreads();
            if (tid < 128) CB1P[(chunk * 2 + kv) * 128 + tid] = (red[tid] + red[128 + tid]) + (red[256 + tid] + red[384 + tid]);
            __syncthreads();
        }
        __syncthreads();
        LAS float* scr = (LAS float*)(lds + wave * 8448);
        constexpr int I_WIN = 16 * 160, I_PA = 8 * 32, I_OUT = 16 * 32, I_G = 16 * 88, I_D = 44 * 32, I_C1 = 32 * 4, I_C2 = 2 * 2;
        constexpr int NITEMS = I_WIN + 2 * I_PA + I_OUT + 2 * I_G + I_D + 2 * I_C1 + 2 * I_C2;
        for (int it = gw; it < NITEMS; it += NGW) {
            int r = it;
            if (r < I_WIN) { transpose_item(w_in, DM, DIN, WIN, scr, r, 160, lane, MapWin()); continue; } r -= I_WIN;
            if (r < I_PA) { transpose_item(w_pa, 512, DM, WPA, scr, r, 32, lane, MapId()); continue; } r -= I_PA;
            if (r < I_PA) { transpose_item(w_pb, 512, DM, WPB, scr, r, 32, lane, MapId()); continue; } r -= I_PA;
            if (r < I_OUT) { transpose_item(w_out, DM, DM, WOUT, scr, r, 32, lane, MapId()); continue; } r -= I_OUT;
            if (r < I_G) { transpose_item(w_gate, DM, DFF, WGU, scr, r, 88, lane, MapGate()); continue; } r -= I_G;
            if (r < I_G) { transpose_item(w_up, DM, DFF, WGU, scr, r, 88, lane, MapUp()); continue; } r -= I_G;
            if (r < I_D) { transpose_item(w_down, DFF, DM, WD, scr, r, 32, lane, MapId()); continue; } r -= I_D;
            if (r < I_C1) { transpose_item(cw1k, 2048, 128, CW1K, scr, r, 4, lane, MapId()); continue; } r -= I_C1;
            if (r < I_C1) { transpose_item(cw1v, 2048, 128, CW1V, scr, r, 4, lane, MapId()); continue; } r -= I_C1;
            if (r < I_C2) { transpose_item(cw2k, 128, 64, CW2K, scr, r, 2, lane, MapId()); continue; } r -= I_C2;
            transpose_item(cw2v, 128, 64, CW2V, scr, r, 2, lane, MapId());
        }
    }
    SEAM(0);
    if (IN(1)) {
        if (bx < 176) {
            LAS float* inl = (LAS float*)lds; LAS float* red = (LAS float*)(lds + 65536);
            __syncthreads();
            for (int i = tid; i < 16 * 1024; i += NTHREADS) { const int k = i >> 4, b = i & 15; inl[i] = MOD[b * 6144 + 3 * DM + k]; }
            __syncthreads();
            for (int u = bx; u < 176; u += G) {
                if (u < 88) gemv16_unit(inl, red, w_gate, DFF, 32 * u, (const float*)nullptr, BIASGU, DGU, OmGate(), tid);
                else gemv16_unit(inl, red, w_up, DFF, 32 * (u - 88), (const float*)nullptr, BIASGU, DGU, OmUp(), tid);
            }
        }
        for (int kv = G - 1 - bx; kv < 2; kv += G) {

            if (tid < 128) { float s = 0.f;
#pragma unroll 8
                for (int cpart = 0; cpart < 32; ++cpart) s += CB1P[(cpart * 2 + kv) * 128 + tid];
                CB1[kv * 128 + tid] = s; }
        }
        unsigned* wq1 = (unsigned*)(ws + 3 * MiB + 15360 + 192);
        LAS unsigned* wql1 = (LAS unsigned*)(lds + LDS_BYTES - 32);
        unsigned nxt_ = 0u;
        if (tid == 0) nxt_ = __hip_atomic_fetch_add(wq1, 16u, __ATOMIC_RELAXED, __HIP_MEMORY_SCOPE_AGENT);
        for (;;) {
            __syncthreads();
            if (tid == 0) *wql1 = nxt_;
            __syncthreads();
            const int base_ = (int)*wql1;
            if (base_ >= MT) break;
            if (tid == 0) nxt_ = __hip_atomic_fetch_add(wq1, 16u, __ATOMIC_RELAXED, __HIP_MEMORY_SCOPE_AGENT);
        for (int m = base_ + 2 * wave; m < base_ + 2 * wave + 2; ++m) {
            const int b = m >> 11;
            const f32x4* xr = (const f32x4*)(x + (size_t)m * DM) + lane;
            f32x4 v[4]; float s = 0.f;
#pragma unroll
            for (int j = 0; j < 4; ++j) { v[j] = __builtin_nontemporal_load(xr + 64 * j); s += (v[j][0] * v[j][0] + v[j][1] * v[j][1]) + (v[j][2] * v[j][2] + v[j][3] * v[j][3]); }
            const float rstd = 1.0f / sqrtf(wave_sum(s) * (1.0f / DM) + RMS_EPS);
            u32x2* o8 = (u32x2*)(H + (size_t)m * DM) + lane;
#pragma unroll
            for (int j = 0; j < 4; ++j) {
                const int col = 4 * lane + 256 * j;
                const f32x4 gg = *(const f32x4*)(g_mix + col), sh = *(const f32x4*)(MOD + b * 6144 + col), sc = *(const f32x4*)(MOD + b * 6144 + DM + col);
                const f32x4 r = v[j] * rstd * gg * (sc + 1.0f) + sh;
                u32x2 w; w.x = cvtpk(r[0], r[1]); w.y = cvtpk(r[2], r[3]);
                o8[64 * j] = w;
            }
        }
        }
    }
    SEAM(1);
    if (IN(2)) {
        __syncthreads();
        pg8::Gemm g{H, WIN, MT, DINP, DM}; pg8::StaticOrder S; S.init(MT, DINP, G, bx);
        EpiProj E{PROJ};
        pg8::gemm_phase<EpiProj, pg8::StaticOrder, true, true>(lds, g, S, E);
    }
    SEAM(2);
    if (IN(3)) {
        __syncthreads();
        for (int rep_ = 0; rep_ < REP_P3; ++rep_)
        for (int u = bx; u < 256; u += G) {
            const int kv = u & 1, nq = (u >> 1) & 3, g = (u >> 3) & 1, b = u >> 4;
            compress_unit(lds, PROJ, CB1 + kv * 128, kv ? CW1V : CW1K, kv ? CW2V : CW2K, kv ? VC : KC, b, g, kv, nq, tid);
        }
    }
    SEAM(3);
    for (int rep_ = 0; rep_ < REP_SYNC; ++rep_) GRIDSYNC();
    if (IN(4)) {
        unsigned* wq = (unsigned*)(ws + 3 * MiB + 15360 + 512);
        LAS unsigned* wql = (LAS unsigned*)(lds + LDS_BYTES - 32);
        if (tid == 0) { wql[1] = bar.x & 7u; wql[2] = 0u; }
        for (;;) {
            __syncthreads();
            if (tid == 0) {
                unsigned v, qcur = wql[1], tried = wql[2];
                for (;;) { v = __hip_atomic_fetch_add(wq + qcur * 16, 1u, __ATOMIC_RELAXED, __HIP_MEMORY_SCOPE_AGENT); if (v < 256u || tried == 7u) break; qcur = (qcur + 1u) & 7u; ++tried; }
                wql[1] = qcur; wql[2] = tried;
                *wql = v < 256u ? (qcur << 8) | v : 0xffffffffu;
            }
            __syncthreads();
            const unsigned u = *wql;
            if (u == 0xffffffffu) break;
            const int q = (int)(u >> 8), i = (int)(u & 255u);
            if (i < 128) { const int c = 31 - (i >> 2), j = i & 3; nsa_unit(lds, PROJ, KC, VC, OA, 2 * q + (j >> 1), j & 1, c, tid); }
            else { const int k = i - 128, qb = 7 - (k >> 4), j = k & 15; sb_unit<0>(lds, PROJ, OB, 2 * q + (j >> 3), j & 7, qb, tid); }
        }
    }
    SEAM(4);
    if (IN(5)) {
        __syncthreads();
        pg8::Gemm g{OA, WPA, MT, DM, 512}; pg8::StaticOrder S; S.init(MT, DM, G, bx);
        EpiMerge<0> E{PROJ, Y};
        pg8::gemm_phase<EpiMerge<0>, pg8::StaticOrder, true, true>(lds, g, S, E);
    }
    STAMP(6);
    if (IN(6)) {
        __syncthreads();
        pg8::Gemm g{OB, WPB, MT, DM, 512}; pg8::StaticOrder S; S.init(MT, DM, G, bx);
        EpiMerge<1> E{PROJ, Y};
        pg8::gemm_phase<EpiMerge<1>, pg8::StaticOrder, true, true>(lds, g, S, E);
    }
    SEAM(6);
    if (IN(7)) {
        __syncthreads();
        pg8::Gemm g{Y, WOUT, MT, DM, DM}; pg8::StaticOrder S; S.init(MT, DM, G, bx);
        const bool alt = args.pad == 1;
        EpiOut E{x, alt ? (bf16_t*)(ws + WS_PROJ) : X1B, alt ? (bf16_t*)(ws + WS_PROJ + 64 * MiB) : APRE, MOD, g_ffn, alt ? (float*)(ws + WS_PROJ + 130 * MiB) : SUMSQ2};
        pg8::gemm_phase<EpiOut, pg8::StaticOrder, true, true>(lds, g, S, E);
    }
    SEAM(7);
    if (IN(8)) {
        __syncthreads();
        pg8::Gemm g{APRE, WGU, MT, DGU, DM}; pg8::StaticOrder S; S.init(MT, DGU, G, bx);
        EpiGU E{SUMSQ2, BIASGU, ACT};
        pg8::gemm_phase<EpiGU, pg8::StaticOrder, true, true>(lds, g, S, E);
    }
    SEAM(8);
    if (IN(9)) {
        __syncthreads();
        pg8::Gemm g{ACT, WD, MT, DM, DFF}; pg8::StaticOrder S; S.init(MT, DM, G, bx);
        const bool alt = args.pad == 1;
        EpiDown E{X1B, alt ? (bf16_t*)(ws + 400 * MiB) : X2B, MOD, alt ? (float*)(ws + 420 * MiB) : SUMSQ3};
        pg8::gemm_phase<EpiDown, pg8::StaticOrder, true, true>(lds, g, S, E);
    }
    SEAM(9);
    if (IN(10)) {
        for (int m = gw; m < MT; m += NGW) {
            const float rstd = 1.0f / sqrtf(SUMSQ3[m] * (1.0f / DM) + RMS_EPS);
            const u32x2* xr = (const u32x2*)(X2B + (size_t)m * DM) + lane;
            f32x4* xw = (f32x4*)((args.pad == 1 ? (float*)(ws + WS_PROJ) : out) + (size_t)m * DM) + lane;
            u32x2 xi[4];
#pragma unroll
            for (int j = 0; j < 4; ++j) xi[j] = xr[64 * j];
#pragma unroll
            for (int j = 0; j < 4; ++j) { const f32x4 gg = *(const f32x4*)(g_fin + 4 * lane + 256 * j);
                const f32x4 xv = {__uint_as_float(xi[j].x << 16), __uint_as_float(xi[j].x & 0xffff0000u), __uint_as_float(xi[j].y << 16), __uint_as_float(xi[j].y & 0xffff0000u)};
                __builtin_nontemporal_store(xv * rstd * gg, xw + 64 * j); }
        }
    }
    STAMP(11);
#ifdef TS_PROBE
    GRIDSYNC();
    if (bx == 0) {
        LAS float* lf = (LAS float*)lds;
        if (tid == 0) {
            const float v1 = (float)(tsbuf[TSA1] - tsbuf[TSA0]) * 0.1f;
            const float v2 = (float)(tsbuf[TSB1] - tsbuf[TSB0]) * 0.01f;
            out[0] = v1; lf[0] = v2;
        }
        __syncthreads();
        const float v2 = lf[0];
        for (int i = 1 + tid; i <= (1 << 20); i += NTHREADS) out[i] += v2;
    }
#endif
#undef IN
#undef SEAM
}

#ifndef MK_N_LAUNCHES
#define MK_N_LAUNCHES 1
#endif

extern "C" void kernel_launch(void* const* d_in, const int* in_sizes, int n_in, void* d_out, int out_size, void* d_ws, size_t ws_size, hipStream_t stream) {
    static int grid = 0;
    if (grid == 0) {
        if (n_in != 20 || out_size != MT * DM || ws_size < WS_END) { fprintf(stderr, "kernel_launch: unexpected shapes n_in %d out %d ws %zu\n", n_in, out_size, ws_size); grid = -1; return; }
        int dev = 0, cus = 0, per_cu = 0;
        hipGetDevice(&dev);
        hipDeviceGetAttribute(&cus, hipDeviceAttributeMultiprocessorCount, dev);
        if (hipFuncSetAttribute((const void*)mega_fwd, hipFuncAttributeMaxDynamicSharedMemorySize, LDS_BYTES) != hipSuccess) { fprintf(stderr, "kernel_launch: hipFuncSetAttribute failed\n"); grid = -1; return; }
        if (hipOccupancyMaxActiveBlocksPerMultiprocessor(&per_cu, (const void*)mega_fwd, NTHREADS, LDS_BYTES) != hipSuccess || per_cu < 1) { fprintf(stderr, "kernel_launch: occupancy query gave %d\n", per_cu); per_cu = 1; }
        (void)hipGetLastError();
        grid = cus * 1;
        if (grid <= 0) grid = 256;
    }
    if (grid < 0) return;
    if (hipMemsetAsync((char*)d_ws + 3 * MiB, 0, 16384, stream) != hipSuccess) { fprintf(stderr, "kernel_launch: memset failed\n"); return; }
    Args a{};
    for (int i = 0; i < 20; ++i) a.in[i] = (const float*)d_in[i];
    a.out = (float*)d_out; a.ws = (unsigned char*)d_ws;
#if MK_N_LAUNCHES == 1
    a.ph_lo = 0; a.ph_hi = N_PHASES; a.coop = 1; a.pad = 0;
    void* kargs[] = {&a};
    hipError_t e = hipLaunchCooperativeKernel((const void*)mega_fwd, dim3(grid), dim3(NTHREADS), kargs, LDS_BYTES, stream);
    if (e != hipSuccess) fprintf(stderr, "kernel_launch: cooperative launch failed: %s (grid %d)\n", hipGetErrorString(e), grid);
#else
    const int cuts[] = {0, 1, 2, 3, 4, 5, 7, 8, 9, 10, 11};
    for (int li = 0; li + 1 < (int)(sizeof(cuts) / sizeof(int)); ++li) {
        a.ph_lo = cuts[li]; a.ph_hi = cuts[li + 1]; a.coop = 0; a.pad = 0;
        hipLaunchKernelGGL(mega_fwd, dim3(grid), dim3(NTHREADS), LDS_BYTES, stream, a);
#ifdef DUP_PHASE
        if (cuts[li] == DUP_PHASE) { a.pad = 1; hipLaunchKernelGGL(mega_fwd, dim3(grid), dim3(NTHREADS), LDS_BYTES, stream, a); a.pad = 0; }
        if (DUP_PHASE == 99 && li == 0) { a.ph_lo = 0; a.ph_hi = 0; hipLaunchKernelGGL(mega_fwd, dim3(grid), dim3(NTHREADS), LDS_BYTES, stream, a); }
#endif
    }
#endif
}
```
